# Optimizing an MI355X kernel written in HIP

```python
import jax
import jax.numpy as jnp
from jax import lax
import numpy as np


D_MODEL = 1024
BATCH = 16
SEQ = 2048
DEPTH = 4

GRID_W = 64
CTX_LEN = 256
HEAD_DIM = 64
MIX_WIDTH = D_MODEL
NA_HEADS = 8
NA_WIN_R = 8
NA_WIN_C = 16
NA_QCOLS = 16
NA_KCOLS = NA_QCOLS + NA_WIN_C
MLA_HEADS = 8
MLA_Q_RANK = 384
MLA_KV_RANK = 256
MLA_NOPE = 64
MLA_ROPE = 32
MLA_V = 64
ATTN_BLOCK = 128
SWA_Q_HEADS = 16
SWA_KV_HEADS = 2
SWA_WINDOW = 128
SWA_BLOCK = 128
D_FF = 2816
CONV_W = 3
ROPE_BASE = 10000.0
LN_EPS = 1e-6
RMS_EPS = 1e-6
NEG = -1e30
DEEPNORM_ALPHA = (2 * DEPTH) ** 0.25
DEEPNORM_BETA = (8 * DEPTH) ** -0.25
N_EVEN = (DEPTH + 1) // 2
N_ODD = DEPTH // 2
NA_WIDTH = NA_HEADS * HEAD_DIM
EVEN_SPLITS = [NA_WIDTH, 2 * NA_WIDTH, 3 * NA_WIDTH, 3 * NA_WIDTH + MLA_Q_RANK, 3 * NA_WIDTH + MLA_Q_RANK + MLA_KV_RANK]
EVEN_IN = 3 * NA_WIDTH + MLA_Q_RANK + MLA_KV_RANK + MLA_ROPE
ODD_SPLITS = [SWA_Q_HEADS * HEAD_DIM, (SWA_Q_HEADS + SWA_KV_HEADS) * HEAD_DIM]
ODD_IN = (SWA_Q_HEADS + 2 * SWA_KV_HEADS) * HEAD_DIM

kernel_name = 'hybrid_natten_mla_swa_dit_prefix'


def layer_norm(x):
    xf = x.astype(jnp.float32)
    mu = jnp.mean(xf, axis=-1, keepdims=True)
    var = jnp.mean(jnp.square(xf - mu), axis=-1, keepdims=True)
    return ((xf - mu) * lax.rsqrt(var + LN_EPS)).astype(x.dtype)


def rms_norm(x, g):
    xf = x.astype(jnp.float32)
    y = xf * lax.rsqrt(jnp.mean(jnp.square(xf), axis=-1, keepdims=True) + RMS_EPS)
    return y.astype(x.dtype) * g


def modulate(h, shift, scale):
    return h * (1 + scale) + shift


def axial_rope(n_tokens, rot_dim, dtype):
    axis_dim = rot_dim // 2
    t = jnp.arange(n_tokens)
    row = (t // GRID_W).astype(jnp.float32)[:, None]
    col = (t % GRID_W).astype(jnp.float32)[:, None]
    inv_freq = ROPE_BASE ** (-jnp.arange(0, axis_dim, 2, dtype=jnp.float32) / axis_dim)
    ar, ac = row * inv_freq, col * inv_freq
    ang = jnp.concatenate([ar, ar, ac, ac], axis=-1)
    return jnp.cos(ang).astype(dtype), jnp.sin(ang).astype(dtype)


def _rotate_half(v):
    a, b = jnp.split(v, 2, axis=-1)
    return jnp.concatenate([-b, a], axis=-1)


def apply_rope(x, cos, sin):
    xr, xc = jnp.split(x, 2, axis=-1)
    return x * cos + jnp.concatenate([_rotate_half(xr), _rotate_half(xc)], axis=-1) * sin


def dense_attention(q, k, v):
    B, T, H, dh = q.shape
    s = jnp.einsum('bqhd,bkhd->bhqk', q, k).astype(jnp.float32) * dh ** -0.5
    p = jax.nn.softmax(s, axis=-1).astype(v.dtype)
    return jnp.einsum('bhqk,bkhd->bqhd', p, v).reshape(B, T, H * dh)


def _na_column_tables():
    n_cb = GRID_W // NA_QCOLS
    q_col = np.arange(GRID_W).reshape(n_cb, NA_QCOLS)
    k_start = np.clip(np.arange(n_cb) * NA_QCOLS - NA_WIN_C // 2, 0, GRID_W - NA_KCOLS)
    k_col = k_start[:, None] + np.arange(NA_KCOLS)
    w_start = np.clip(q_col - NA_WIN_C // 2, 0, GRID_W - NA_WIN_C)
    kc = k_col[:, None, :]
    col_ok = (kc >= w_start[..., None]) & (kc < w_start[..., None] + NA_WIN_C)
    dcol_idx = np.clip(kc - q_col[..., None] + NA_WIN_C - 1, 0, 2 * NA_WIN_C - 2)
    return k_col, col_ok, dcol_idx


def neighbourhood_attention(q, k, v, k_ctx, v_ctx, rpb):
    B, S, H, dh = q.shape
    rows = S // GRID_W
    kr = min(NA_WIN_R, rows)
    n_cb = GRID_W // NA_QCOLS
    n_loc = kr * NA_KCOLS
    k_col, col_ok, dcol_idx = _na_column_tables()
    scale = dh ** -0.5
    qg = q.reshape(B, rows, n_cb, NA_QCOLS, H, dh)
    kg = k.reshape(B, rows, GRID_W, H, dh)
    vg = v.reshape(B, rows, GRID_W, H, dh)
    rpb_col = rpb[:, :, dcol_idx]
    mask = col_ok[:, :, None, :]

    def one_row(r):
        r0 = jnp.clip(r - NA_WIN_R // 2, 0, rows - kr)
        q_r = lax.dynamic_index_in_dim(qg, r, axis=1, keepdims=False)
        k_blk = lax.dynamic_slice_in_dim(kg, r0, kr, axis=1)[:, :, k_col]
        v_blk = lax.dynamic_slice_in_dim(vg, r0, kr, axis=1)[:, :, k_col]
        drow_idx = r0 + jnp.arange(kr) - r + NA_WIN_R - 1
        bias = jnp.take(rpb_col, drow_idx, axis=1).transpose(0, 2, 3, 1, 4)
        s_loc = jnp.einsum('bnqhd,bmnkhd->bhnqmk', q_r, k_blk) * scale + bias
        s_loc = jnp.where(mask, s_loc.astype(jnp.float32), NEG).reshape(B, H, n_cb, NA_QCOLS, n_loc)
        s_ctx = jnp.einsum('bnqhd,bchd->bhnqc', q_r, k_ctx).astype(jnp.float32) * scale
        p = jax.nn.softmax(jnp.concatenate([s_loc, s_ctx], axis=-1), axis=-1).astype(v.dtype)
        p_loc = p[..., :n_loc].reshape(B, H, n_cb, NA_QCOLS, kr, NA_KCOLS)
        o = (jnp.einsum('bhnqmk,bmnkhd->bnqhd', p_loc, v_blk)
             + jnp.einsum('bhnqc,bchd->bnqhd', p[..., n_loc:], v_ctx))
        return o.reshape(B, GRID_W, H * dh)

    out = lax.map(one_row, jnp.arange(rows))
    return out.swapaxes(0, 1).reshape(B, S, H * dh)


def mla_attention(qn, qr, kn, kr, v):
    B, T = qn.shape[:2]
    s = jnp.einsum('bqhd,bkhd->bhqk', qn, kn) + jnp.einsum('bqhd,bkd->bhqk', qr, kr)
    p = jax.nn.softmax(s.astype(jnp.float32) * (MLA_NOPE + MLA_ROPE) ** -0.5, axis=-1).astype(v.dtype)
    return jnp.einsum('bhqk,bkhd->bqhd', p, v).reshape(B, T, -1)


def mla_latent(qn, qr, kn, kr, v):
    B, S = qn.shape[:2]
    nb = S // ATTN_BLOCK
    blk = lambda t: t.reshape(B, nb, ATTN_BLOCK, *t.shape[2:]).swapaxes(0, 1)
    out = lax.map(lambda a: mla_attention(a[0], a[1], kn, kr, v), (blk(qn), blk(qr)))
    return out.swapaxes(0, 1).reshape(B, S, -1)


def window_gqa_latent(q, k, v, k_ctx, v_ctx, sink):
    B, S, Hq, dh = q.shape
    Hkv = k.shape[2]
    G = Hq // Hkv
    nb = S // SWA_BLOCK
    span = SWA_BLOCK + 2 * SWA_WINDOW
    scale = dh ** -0.5
    qb = q.reshape(B, nb, SWA_BLOCK, Hkv, G, dh).swapaxes(0, 1)
    pad = ((0, 0), (SWA_WINDOW, SWA_WINDOW), (0, 0), (0, 0))
    kp, vp = jnp.pad(k, pad), jnp.pad(v, pad)
    qi = jnp.arange(SWA_BLOCK)[:, None]
    kk = jnp.arange(span)[None, :]
    band = (kk >= qi) & (kk <= qi + 2 * SWA_WINDOW)
    s_sink = jnp.broadcast_to(sink.astype(jnp.float32).reshape(1, Hkv, G, 1, 1), (B, Hkv, G, SWA_BLOCK, 1))

    def one_block(args):
        n, q_n = args
        start = n * SWA_BLOCK
        k_n = lax.dynamic_slice_in_dim(kp, start, span, axis=1)
        v_n = lax.dynamic_slice_in_dim(vp, start, span, axis=1)
        key_pos = start - SWA_WINDOW + kk
        ok = band & (key_pos >= 0) & (key_pos < S)
        s_loc = jnp.einsum('bqhgd,bkhd->bhgqk', q_n, k_n).astype(jnp.float32) * scale
        s_loc = jnp.where(ok, s_loc, NEG)
        s_ctx = jnp.einsum('bqhgd,bchd->bhgqc', q_n, k_ctx).astype(jnp.float32) * scale
        p = jax.nn.softmax(jnp.concatenate([s_loc, s_ctx, s_sink], axis=-1), axis=-1).astype(v.dtype)
        o = (jnp.einsum('bhgqk,bkhd->bqhgd', p[..., :span], v_n)
             + jnp.einsum('bhgqc,bchd->bqhgd', p[..., span:-1], v_ctx))
        return o.reshape(B, SWA_BLOCK, Hq * dh)

    out = lax.map(one_block, (jnp.arange(nb), qb))
    return out.swapaxes(0, 1).reshape(B, S, Hq * dh)


def gqa_sink_dense(q, k, v, sink):
    B, T, Hq, dh = q.shape
    Hkv = k.shape[2]
    G = Hq // Hkv
    qg = q.reshape(B, T, Hkv, G, dh)
    s = jnp.einsum('bqhgd,bkhd->bhgqk', qg, k).astype(jnp.float32) * dh ** -0.5
    s_sink = jnp.broadcast_to(sink.astype(jnp.float32).reshape(1, Hkv, G, 1, 1), (B, Hkv, G, T, 1))
    p = jax.nn.softmax(jnp.concatenate([s, s_sink], axis=-1), axis=-1)[..., :-1].astype(v.dtype)
    return jnp.einsum('bhgqk,bkhd->bqhgd', p, v).reshape(B, T, Hq * dh)


def conv_ffn(h, w_up, b_up, conv_w, conv_b, w_down, b_down):
    T = h.shape[1]
    u = h @ w_up + b_up
    r = CONV_W // 2
    up = jnp.pad(u, ((0, 0), (r, r), (0, 0)))
    u = sum(up[:, i:i + T] * conv_w[i] for i in range(CONV_W)) + conv_b
    a, g = jnp.split(u, 2, axis=-1)
    return (a * jax.nn.silu(g)) @ w_down + b_down


def even_project(z, q_norm_g, w_uq, kv_norm_g, w_ukv):
    B, T, _ = z.shape
    qa, ka, va, cq, ckv, k_rope = jnp.split(z, EVEN_SPLITS, axis=-1)
    heads = lambda t: t.reshape(B, T, NA_HEADS, HEAD_DIM)
    q = (rms_norm(cq, q_norm_g) @ w_uq).reshape(B, T, MLA_HEADS, MLA_NOPE + MLA_ROPE)
    kv = (rms_norm(ckv, kv_norm_g) @ w_ukv).reshape(B, T, MLA_HEADS, MLA_NOPE + MLA_V)
    return (heads(qa), heads(ka), heads(va), q[..., :MLA_NOPE], q[..., MLA_NOPE:],
            kv[..., :MLA_NOPE], k_rope, kv[..., MLA_NOPE:])


def even_mixer(h, h_ctx, w_in, rpb, q_norm_g, w_uq, kv_norm_g, w_ukv, w_out, rope, with_ctx_out):
    cos, sin = rope
    qa, ka, va, qn, qr, kn, kr, vm = even_project(h @ w_in, q_norm_g, w_uq, kv_norm_g, w_ukv)
    qa_c, ka_c, va_c, qn_c, qr_c, kn_c, kr_c, vm_c = even_project(h_ctx @ w_in, q_norm_g, w_uq, kv_norm_g, w_ukv)
    qr = apply_rope(qr, cos[:, None, :], sin[:, None, :])
    kr = apply_rope(kr, cos, sin)
    o_a = neighbourhood_attention(qa, ka, va, ka_c, va_c, rpb)
    o_b = mla_latent(qn, qr, jnp.concatenate([kn, kn_c], axis=1), jnp.concatenate([kr, kr_c], axis=1),
                     jnp.concatenate([vm, vm_c], axis=1))
    y = jnp.concatenate([o_a, o_b], axis=-1) @ w_out
    if not with_ctx_out:
        return y, None
    o_ac = dense_attention(qa_c, ka_c, va_c)
    o_bc = mla_attention(qn_c, qr_c, kn_c, kr_c, vm_c)
    return y, jnp.concatenate([o_ac, o_bc], axis=-1) @ w_out


def odd_project(z):
    B, T, _ = z.shape
    q, k, v = jnp.split(z, ODD_SPLITS, axis=-1)
    return (q.reshape(B, T, SWA_Q_HEADS, HEAD_DIM), k.reshape(B, T, SWA_KV_HEADS, HEAD_DIM),
            v.reshape(B, T, SWA_KV_HEADS, HEAD_DIM))


def odd_mixer(h, h_ctx, w_in, sink, w_out, rope, with_ctx_out):
    cos, sin = rope
    q, k, v = odd_project(h @ w_in)
    q_c, k_c, v_c = odd_project(h_ctx @ w_in)
    q = apply_rope(q, cos[:, None, :], sin[:, None, :])
    k = apply_rope(k, cos[:, None, :], sin[:, None, :])
    y = window_gqa_latent(q, k, v, k_c, v_c, sink) @ w_out
    if not with_ctx_out:
        return y, None
    return y, gqa_sink_dense(q_c, k_c, v_c, sink) @ w_out


def setup_inputs(seed: int = 0) -> dict:
    key = jax.random.key(seed)
    keys = iter(jax.random.split(key, 24))

    def nrm(shape, scale):
        return jax.random.normal(next(keys), shape, jnp.float32) * scale

    D = D_MODEL
    F2 = 2 * D_FF
    return {
        'x': nrm((BATCH, SEQ, D), 1.0),
        'c': nrm((BATCH, D), 1.0),
        'ctx': nrm((BATCH, CTX_LEN, D), 1.0),
        'c_ctx': nrm((D,), 1.0),
        'w_ada': nrm((DEPTH, D, 6 * D), 0.5 * D ** -0.5),
        'b_ada': nrm((DEPTH, 6 * D), 0.01),
        'na_rpb': nrm((N_EVEN, NA_HEADS, 2 * NA_WIN_R - 1, 2 * NA_WIN_C - 1), 0.1),
        'w_in_even': nrm((N_EVEN, D, EVEN_IN), D ** -0.5),
        'mla_q_norm': 1.0 + nrm((N_EVEN, MLA_Q_RANK), 0.01),
        'w_uq': nrm((N_EVEN, MLA_Q_RANK, MLA_HEADS * (MLA_NOPE + MLA_ROPE)), MLA_Q_RANK ** -0.5),
        'mla_kv_norm': 1.0 + nrm((N_EVEN, MLA_KV_RANK), 0.01),
        'w_ukv': nrm((N_EVEN, MLA_KV_RANK, MLA_HEADS * (MLA_NOPE + MLA_V)), MLA_KV_RANK ** -0.5),
        'w_out_even': nrm((N_EVEN, MIX_WIDTH, D), DEEPNORM_BETA * MIX_WIDTH ** -0.5),
        'w_in_odd': nrm((N_ODD, D, ODD_IN), D ** -0.5),
        'sinks': nrm((N_ODD, SWA_Q_HEADS), 0.5),
        'w_out_odd': nrm((N_ODD, SWA_Q_HEADS * HEAD_DIM, D), DEEPNORM_BETA * (SWA_Q_HEADS * HEAD_DIM) ** -0.5),
        'w_up': nrm((DEPTH, D, F2), D ** -0.5),
        'b_up': nrm((DEPTH, F2), 0.01),
        'conv_w': nrm((DEPTH, CONV_W, F2), CONV_W ** -0.5),
        'conv_b': nrm((DEPTH, F2), 0.01),
        'w_down': nrm((DEPTH, D_FF, D), DEEPNORM_BETA * D_FF ** -0.5),
        'b_down': nrm((DEPTH, D), 0.01),
    }


def reference(x, c, ctx, c_ctx, w_ada, b_ada, na_rpb, w_in_even, mla_q_norm, w_uq, mla_kv_norm, w_ukv,
              w_out_even, w_in_odd, sinks, w_out_odd, w_up, b_up, conv_w, conv_b, w_down, b_down):
    S = x.shape[1]
    rope_mla = axial_rope(S, MLA_ROPE, x.dtype)
    rope_swa = axial_rope(S, HEAD_DIM, x.dtype)
    mod_lat = jnp.einsum('bd,ldk->lbk', jax.nn.silu(c), w_ada) + b_ada[:, None, :]
    mod_ctx = jnp.einsum('d,ldk->lk', jax.nn.silu(c_ctx), w_ada) + b_ada
    z = ctx
    for l in range(DEPTH):
        i = l // 2
        with_ctx = l < DEPTH - 1
        sh_m, sc_m, g_m, sh_f, sc_f, g_f = jnp.split(mod_lat[l][:, None, :], 6, axis=-1)
        csh_m, csc_m, cg_m, csh_f, csc_f, cg_f = jnp.split(mod_ctx[l], 6, axis=-1)
        h, hc = modulate(x, sh_m, sc_m), modulate(z, csh_m, csc_m)
        if l % 2 == 0:
            y, y_c = even_mixer(h, hc, w_in_even[i], na_rpb[i], mla_q_norm[i], w_uq[i], mla_kv_norm[i],
                                w_ukv[i], w_out_even[i], rope_mla, with_ctx)
        else:
            y, y_c = odd_mixer(h, hc, w_in_odd[i], sinks[i], w_out_odd[i], rope_swa, with_ctx)
        ffn = (w_up[l], b_up[l], conv_w[l], conv_b[l], w_down[l], b_down[l])
        x = layer_norm(DEEPNORM_ALPHA * x + g_m * y)
        x = layer_norm(DEEPNORM_ALPHA * x + g_f * conv_ffn(modulate(x, sh_f, sc_f), *ffn))
        if with_ctx:
            z = layer_norm(DEEPNORM_ALPHA * z + cg_m * y_c)
            z = layer_norm(DEEPNORM_ALPHA * z + cg_f * conv_ffn(modulate(z, csh_f, csc_f), *ffn))
    return x
```

```cpp
#include <hip/hip_runtime.h>
#include <hip/hip_cooperative_groups.h>
#include <cstdint>
#include <cstdio>
namespace cg = cooperative_groups;

#ifndef MK_PER_PHASE_LAUNCH
#define MK_PER_PHASE_LAUNCH 0
#endif

#define LAS __attribute__((address_space(3)))
#define GET_TID() int tid_ = threadIdx.x; asm volatile("" : "+v"(tid_)); const int tid = tid_, lane = tid & 63, wid = __builtin_amdgcn_readfirstlane(tid >> 6); const int gw = blockIdx.x * 8 + wid; (void)gw; (void)lane; (void)tid
#ifdef ONLY
#define EN(x) ((x) == ONLY)
#else
#define EN(x) true
#endif
typedef unsigned short bf16_t;
typedef short bf16x8 __attribute__((ext_vector_type(8)));
typedef short s16x4 __attribute__((ext_vector_type(4)));
typedef float f32x4 __attribute__((ext_vector_type(4)));
typedef float f32x16 __attribute__((ext_vector_type(16)));
typedef unsigned u32x4 __attribute__((ext_vector_type(4)));
typedef unsigned u32x2 __attribute__((ext_vector_type(2)));

constexpr int DM = 1024, NBATCH = 16, SEQL = 2048, CTXL = 256;
constexpr int ML = NBATCH * SEQL;
constexpr int MC = NBATCH * CTXL;
constexpr int MT = ML + MC;
constexpr int ZE = 2304, ZO = 1280, FFH = 2816, FF2 = 5632;
constexpr float LOG2E = 1.4426950408889634f;
constexpr float QS64 = 0.125f * LOG2E;
constexpr float QS96 = 0.10206207261596575f * LOG2E;
constexpr float ALPHA = 1.681792830507429f;
constexpr float LN_EPS = 1e-6f, RMS_EPS = 1e-6f;

constexpr size_t MiB = 1u << 20;
constexpr size_t WS_MODS = 1 * MiB;
constexpr size_t WS_TAB = 3 * MiB;
constexpr size_t WS_XC = 4 * MiB;
constexpr size_t WS_W = 20 * MiB;
constexpr size_t WS_HO = 112 * MiB;
constexpr size_t WS_Z = 184 * MiB;
constexpr size_t WS_Q2 = 346 * MiB;
constexpr size_t WS_KV2 = 400 * MiB;
constexpr size_t WS_G = WS_Z;
constexpr size_t WS_HALO = WS_KV2;
constexpr size_t WS_STAT = 472 * MiB;
constexpr size_t WS_SSQ = 473 * MiB;
constexpr size_t WS_END = 476 * MiB;

constexpr size_t W_EVEN = 2359296 + 294912 + 262144 + 1048576;
constexpr size_t W_ODD = 1310720 + 1048576;
constexpr size_t W_FFN = 5767168 + 2883584;
__host__ __device__ constexpr size_t w_layer_off(int l) { return (size_t)(l / 2) * (W_EVEN + W_ODD) + (size_t)l * W_FFN + ((l & 1) ? W_EVEN : 0); }
__host__ __device__ constexpr size_t w_win(int l) { return w_layer_off(l); }
__host__ __device__ constexpr size_t w_uq(int l) { return w_layer_off(l) + 2359296; }
__host__ __device__ constexpr size_t w_ukv(int l) { return w_layer_off(l) + 2359296 + 294912; }
__host__ __device__ constexpr size_t w_wout(int l) { return w_layer_off(l) + ((l & 1) ? 1310720 : (2359296 + 294912 + 262144)); }
__host__ __device__ constexpr size_t w_up(int l) { return w_wout(l) + 1048576; }
__host__ __device__ constexpr size_t w_down(int l) { return w_up(l) + 5767168; }
static_assert(w_down(3) + 2883584 == 47251456, "weight map");
static_assert(WS_W + 47251456ull * 2 <= WS_HO, "weight region");

constexpr int LDS_BYTES = 147456;
constexpr int PROBE_KIND = -1;
constexpr int PROBE_XSYNC = 0;

__device__ __forceinline__ unsigned cvt_pk_bf16(float lo, float hi) { unsigned r; asm("v_cvt_pk_bf16_f32 %0, %1, %2" : "=v"(r) : "v"(lo), "v"(hi)); return r; }
typedef float f32x2_cv __attribute__((ext_vector_type(2))); typedef __bf16 bf16x2_cv __attribute__((ext_vector_type(2)));
__device__ __forceinline__ unsigned cvt_pk_bf16_m(float lo, float hi) { const f32x2_cv v = {lo, hi}; const bf16x2_cv b = __builtin_convertvector(v, bf16x2_cv); return __builtin_bit_cast(unsigned, b); }
__device__ __forceinline__ float bf_lo(unsigned w) { return __uint_as_float(w << 16); }
__device__ __forceinline__ float bf_hi(unsigned w) { return __uint_as_float(w & 0xffff0000u); }

namespace pg8 {
constexpr int BM = 256, BK = 64, HALF = 128, HTB = HALF * BK * 2, STAGE_BYTES = 8 * HTB, NXCD = 8, WGM = 8;
__host__ __device__ __forceinline__ int lds_byte(int r, int c) { const int st = (r >> 4) * 2 + (c >> 5), rr = r & 15, cc = c & 31, ob = rr * 64 + cc * 2; return st * 1024 + (ob ^ (((ob >> 9) & 1) << 5)); }
__host__ __device__ __forceinline__ void stage_rc(int b, int& R, int& C) { const int st = b / 1024, sb = b % 1024, swz = sb ^ (((sb >> 9) & 1) << 5); R = (st >> 1) * 16 + swz / 64; C = (st & 1) * 32 + (swz % 64) / 2; }
__host__ __device__ __forceinline__ int perm32(int rho) { const int n = rho >> 4, i = rho & 15; return 8 * (i >> 2) + 4 * n + (i & 3); }
struct Unit { int pm, pn; };
struct Gemm { const bf16_t* A; const bf16_t* Bt; int M, N, K, lda; };
struct StaticOrder {
    int nM, nN, nwg, G, c, pm_off;
    __device__ void init(int M, int N, int G_, int c_, int pm_off_ = 0) { nM = M / BM; nN = N / BM; nwg = nM * nN; G = G_; c = c_; pm_off = pm_off_; }
    __device__ bool next(int i, Unit& u) const {
        const long L = (long)i * G + c; if (L >= nwg) return false;
        int wgid = (int)L; { const int q = nwg / NXCD, r = nwg % NXCD, xcd = wgid % NXCD, off = wgid / NXCD; wgid = (xcd < r ? xcd * (q + 1) : r * (q + 1) + (xcd - r) * q) + off; }
        const int nig = WGM * nN, gid = wgid / nig, fm = gid * WGM, gsz = (nM - fm) < WGM ? (nM - fm) : WGM;
        u.pm = pm_off + fm + ((wgid % nig) % gsz); u.pn = (wgid % nig) / gsz; return true;
    }
};
template <class Epi>
__device__ __forceinline__ void gemm_phase(LAS unsigned char* lds, const Gemm g, const StaticOrder& S, const Epi& E) {
    int tid_ = threadIdx.x; asm volatile("" : "+v"(tid_));
    const int tid = tid_, wid = __builtin_amdgcn_readfirstlane(tid >> 6), lane = tid & 63, wr = wid >> 2, wc = wid & 3, fr = lane & 15, fq = lane >> 4;
    const int K = g.K, nt = K / BK, lda = g.lda;
    unsigned voffA[2], voffB[2];
#pragma unroll
    for (int i = 0; i < 2; ++i) { int R, C; stage_rc(tid * 16 + i * 8192, R, C); const int Rb = (R & ~31) + perm32(R & 31);
        const int Ra = (R & ~63) + 4 * (R & 15) + ((R >> 4) & 3);
        voffA[i] = (unsigned)(Ra * lda + C) * 2u; voffB[i] = (unsigned)(Rb * K + C) * 2u; }
    const size_t kstep = (size_t)(BK * 2);
    const size_t hstepA = (size_t)HALF * lda * 2, hstepB = (size_t)HALF * K * 2;
    const size_t tstepA = 2 * hstepA, tstepB = 2 * hstepB;
    const unsigned ldsw = (unsigned)wid * 1024u;
    const int aoff = lds_byte(wr * 64 + fr, fq * 8), boff = lds_byte(wc * 32 + fr, fq * 8);
#define PG8_SA(b, h) (((b) * 2 + (h)) * HTB)
#define PG8_SB(b, h) ((4 + (b) * 2 + (h)) * HTB)
#define PG8_STAGE(bufoff, gbase, voff) do { _Pragma("unroll") for (int _i = 0; _i < 2; ++_i) \
        __builtin_amdgcn_global_load_lds((const unsigned*)((const char*)(gbase) + (voff)[_i]), (LAS unsigned*)(lds + (bufoff) + ldsw + _i * 8192), 16, 0, 0); } while (0)
#define PG8_LDA(dst, b, h) do { _Pragma("unroll") for (int m = 0; m < 4; ++m) _Pragma("unroll") for (int k = 0; k < 2; ++k) dst[m][k] = *(const LAS bf16x8*)(lds + PG8_SA(b, h) + aoff + m * 2048 + k * 1024); } while (0)
#define PG8_LDB(dst, b, h) do { _Pragma("unroll") for (int n = 0; n < 2; ++n) _Pragma("unroll") for (int k = 0; k < 2; ++k) dst[n][k] = *(const LAS bf16x8*)(lds + PG8_SB(b, h) + boff + n * 2048 + k * 1024); } while (0)
#define PG8_MMA(ai, bj, At, Bt) do { __builtin_amdgcn_s_setprio(1); _Pragma("unroll") for (int m = 0; m < 4; ++m) _Pragma("unroll") for (int n = 0; n < 2; ++n) _Pragma("unroll") for (int k = 0; k < 2; ++k) \
        acc[ai][bj][m][n] = __builtin_amdgcn_mfma_f32_16x16x32_bf16(Bt[n][k], At[m][k], acc[ai][bj][m][n], 0, 0, 0); __builtin_amdgcn_s_setprio(0); } while (0)
#define PG8_WAIT_V(n) asm volatile("s_waitcnt vmcnt(" #n ")" ::: "memory")
#define PG8_WAIT_L(n) asm volatile("s_waitcnt lgkmcnt(" #n ")" ::: "memory")
#define PG8_BAR __builtin_amdgcn_s_barrier()
#define PG8_SCHED __builtin_amdgcn_sched_barrier(0)
    Unit cur, nxt; int ui = 0;
    if (!S.next(0, cur)) return;
    f32x4 acc[2][2][4][2];
#pragma unroll
    for (int a = 0; a < 2; ++a)
#pragma unroll
        for (int b = 0; b < 2; ++b)
#pragma unroll
            for (int m = 0; m < 4; ++m)
#pragma unroll
                for (int n = 0; n < 2; ++n) acc[a][b][m][n] = (f32x4){0.f, 0.f, 0.f, 0.f};
    bf16x8 At[4][2], B0[2][2], B1[2][2];
    const char* cA = (const char*)g.A + (size_t)cur.pm * tstepA; const char* cB = (const char*)g.Bt + (size_t)cur.pn * tstepB;
    PG8_STAGE(PG8_SB(0, 0), cB, voffB); PG8_STAGE(PG8_SB(0, 1), cB + hstepB, voffB); PG8_STAGE(PG8_SA(0, 0), cA, voffA); PG8_STAGE(PG8_SA(0, 1), cA + hstepA, voffA);
    if (wr == 1) PG8_BAR;
    PG8_WAIT_V(2); PG8_BAR;
    PG8_STAGE(PG8_SB(1, 0), cB + kstep, voffB); PG8_STAGE(PG8_SA(1, 0), cA + kstep, voffA); PG8_STAGE(PG8_SB(1, 1), cB + hstepB + kstep, voffB);
    PG8_WAIT_V(6); PG8_BAR;
    for (;;) {
        const bool has_next = S.next(ui + 1, nxt);
        const char* nA = has_next ? (const char*)g.A + (size_t)nxt.pm * tstepA : cA; const char* nB = has_next ? (const char*)g.Bt + (size_t)nxt.pn * tstepB : cB;
        for (int t = 0; t < nt; t += 2) {
            const bool last = (t == nt - 2);
            const char* a1 = cA + (size_t)(t + 1) * kstep;
            const char* a2 = last ? nA : cA + (size_t)(t + 2) * kstep; const char* b2 = last ? nB : cB + (size_t)(t + 2) * kstep;
            const char* a3 = a2 + kstep; const char* b3 = b2 + kstep;
            PG8_LDB(B0, 0, 0); PG8_LDB(B1, 0, 1); PG8_SCHED; PG8_LDA(At, 0, 0); PG8_STAGE(PG8_SA(1, 1), a1 + hstepA, voffA);
            PG8_WAIT_V(8); PG8_WAIT_L(0); PG8_BAR; PG8_MMA(0, 0, At, B0); PG8_MMA(0, 1, At, B1); PG8_BAR; PG8_SCHED;
            PG8_LDA(At, 0, 1); PG8_STAGE(PG8_SB(0, 0), b2, voffB); PG8_STAGE(PG8_SB(0, 1), b2 + hstepB, voffB); PG8_STAGE(PG8_SA(0, 0), a2, voffA);
            PG8_WAIT_V(8); PG8_WAIT_L(0); PG8_BAR; PG8_MMA(1, 0, At, B0); PG8_MMA(1, 1, At, B1); PG8_BAR; PG8_SCHED;
            PG8_LDB(B0, 1, 0); PG8_LDB(B1, 1, 1); PG8_SCHED; PG8_LDA(At, 1, 0); PG8_STAGE(PG8_SA(0, 1), a2 + hstepA, voffA);
            PG8_WAIT_V(8); PG8_WAIT_L(0); PG8_BAR; PG8_MMA(0, 0, At, B0); PG8_MMA(0, 1, At, B1); PG8_BAR; PG8_SCHED;
            PG8_LDA(At, 1, 1); PG8_STAGE(PG8_SB(1, 0), b3, voffB); PG8_STAGE(PG8_SB(1, 1), b3 + hstepB, voffB); PG8_STAGE(PG8_SA(1, 0), a3, voffA);
            PG8_WAIT_V(8); PG8_WAIT_L(0); PG8_BAR; PG8_MMA(1, 0, At, B0); PG8_MMA(1, 1, At, B1); PG8_BAR; PG8_SCHED;
        }
        if (wr == 0) PG8_BAR;
        E(acc, cur, wr, wc, fr, fq);
        if (!has_next) break;
#pragma unroll
        for (int a = 0; a < 2; ++a)
#pragma unroll
            for (int b = 0; b < 2; ++b)
#pragma unroll
                for (int m = 0; m < 4; ++m)
#pragma unroll
                    for (int n = 0; n < 2; ++n) acc[a][b][m][n] = (f32x4){0.f, 0.f, 0.f, 0.f};
        cur = nxt; cA = nA; cB = nB; ++ui;
        if (wr == 1) PG8_BAR;
    }
    PG8_WAIT_V(0);
    PG8_BAR;
#undef PG8_SA
#undef PG8_SB
#undef PG8_STAGE
#undef PG8_LDA
#undef PG8_LDB
#undef PG8_MMA
#undef PG8_WAIT_V
#undef PG8_WAIT_L
#undef PG8_BAR
#undef PG8_SCHED
}
}
using pg8::Unit;

__device__ __forceinline__ void rope_apply(f32x4& v0, f32x4& v1, int kind, int row, int wc, int fq, const float* tabM, const float* tabS) {
    const int t = row & 2047, gr = t >> 6, gc = t & 63;
    const float* tb; float sgn; f32x4 p0, p1;
    if (kind == 1) {
        const int pos = (fq < 2) ? gr : gc; tb = tabM + pos * 16; sgn = (fq & 1) ? 1.f : -1.f;
#pragma unroll
        for (int e = 0; e < 4; ++e) { p0[e] = __shfl_xor(v0[e], 16); p1[e] = __shfl_xor(v1[e], 16); }
    } else {
        const int pos = (wc & 1) ? gc : gr; tb = tabS + pos * 32 + (fq & 1) * 16; sgn = (fq & 2) ? 1.f : -1.f;
#pragma unroll
        for (int e = 0; e < 4; ++e) { p0[e] = __shfl_xor(v0[e], 32); p1[e] = __shfl_xor(v1[e], 32); }
    }
    const f32x4 c0 = *(const f32x4*)(tb), c1 = *(const f32x4*)(tb + 4), c2 = *(const f32x4*)(tb + 8), c3 = *(const f32x4*)(tb + 12);
    v0[0] = v0[0] * c0[0] + sgn * p0[0] * c0[1]; v0[1] = v0[1] * c0[2] + sgn * p0[1] * c0[3];
    v0[2] = v0[2] * c1[0] + sgn * p0[2] * c1[1]; v0[3] = v0[3] * c1[2] + sgn * p0[3] * c1[3];
    v1[0] = v1[0] * c2[0] + sgn * p1[0] * c2[1]; v1[1] = v1[1] * c2[2] + sgn * p1[1] * c2[3];
    v1[2] = v1[2] * c3[0] + sgn * p1[2] * c3[1]; v1[3] = v1[3] * c3[2] + sgn * p1[3] * c3[3];
}
__device__ __forceinline__ void store_bf16x8(bf16_t* p, f32x4 v0, f32x4 v1) {
    u32x4 w; w.x = cvt_pk_bf16(v0[0], v0[1]); w.y = cvt_pk_bf16(v0[2], v0[3]); w.z = cvt_pk_bf16(v1[0], v1[1]); w.w = cvt_pk_bf16(v1[2], v1[3]);
    *(u32x4*)p = w;
}

struct EpiZ {
    bf16_t* Z; int ldz; int odd; const float* tabM; const float* tabS; float* ssq;
    __device__ __forceinline__ void operator()(const f32x4 (&acc)[2][2][4][2], const Unit& u, int wr_in, int wc_in, int fr_in, int fq_in) const {
        int fr = fr_in, fq = fq_in, wr = wr_in, wc = wc_in; asm volatile("" : "+v"(fr), "+v"(fq), "+s"(wr), "+s"(wc));
        const bool lat = u.pm < 128;
#pragma unroll
        for (int bj = 0; bj < 2; ++bj) {
            const int g32 = u.pn * 8 + bj * 4 + wc;
            if (!odd && g32 >= 48 && g32 < 68) {
#pragma unroll
                for (int ai = 0; ai < 2; ++ai)
#pragma unroll
                    for (int m = 0; m < 4; ++m) {
                        const f32x4 a = acc[ai][bj][m][0], b = acc[ai][bj][m][1];
                        float ss = (a[0] * a[0] + a[1] * a[1]) + (a[2] * a[2] + a[3] * a[3]) + (b[0] * b[0] + b[1] * b[1]) + (b[2] * b[2] + b[3] * b[3]);
                        ss += __shfl_xor(ss, 16); ss += __shfl_xor(ss, 32);
                        if (fq == 0) ssq[(size_t)(u.pm * 256 + ai * 128 + wr * 64 + 4 * fr + m) * 20 + (g32 - 48)] = ss;
                    }
            }
            int rope = 0; float sc = 1.f;
            if (!odd) { if (g32 < 16) sc = QS64; if (g32 == 68 && lat) rope = 1; }
            else { if (g32 < 32) sc = QS64; if (g32 < 36 && lat) rope = 2; }
            const int col0 = g32 * 32 + 8 * fq;
#pragma unroll
            for (int ai = 0; ai < 2; ++ai)
#pragma unroll
                for (int m = 0; m < 4; ++m) {
                    const int row = u.pm * 256 + ai * 128 + wr * 64 + 4 * fr + m;
                    f32x4 v0 = acc[ai][bj][m][0], v1 = acc[ai][bj][m][1];
                    if (rope) rope_apply(v0, v1, rope, row, wc, fq, tabM, tabS);
                    v0 = v0 * sc; v1 = v1 * sc;
                    store_bf16x8(Z + (size_t)row * ldz + col0, v0, v1);
                }
        }
    }
};
struct EpiQK {
    bf16_t* O; int ldo; const float* ssq; int nslot; float invn; int isq; const float* tabM;
    __device__ __forceinline__ void operator()(const f32x4 (&acc)[2][2][4][2], const Unit& u, int wr_in, int wc_in, int fr_in, int fq_in) const {
        int fr = fr_in, fq = fq_in, wr = wr_in, wc = wc_in; asm volatile("" : "+v"(fr), "+v"(fq), "+s"(wr), "+s"(wc));
        const bool lat = u.pm < 128;
        const float sc = isq ? QS96 : 1.f;
#pragma unroll
        for (int ai = 0; ai < 2; ++ai)
#pragma unroll
            for (int m = 0; m < 4; ++m) {
                const int row = u.pm * 256 + ai * 128 + wr * 64 + 4 * fr + m;
                const float* sp = ssq + (size_t)row * 20;
                const f32x4 p0 = *(const f32x4*)(sp), p1 = *(const f32x4*)(sp + 4);
                float ss = (p0[0] + p0[1]) + (p0[2] + p0[3]) + (p1[0] + p1[1]) + (p1[2] + p1[3]);
                if (nslot == 12) { const f32x4 p2 = *(const f32x4*)(sp + 8); ss += (p2[0] + p2[1]) + (p2[2] + p2[3]); }
                const float rs = sc / sqrtf(ss * invn + RMS_EPS);
#pragma unroll
                for (int bj = 0; bj < 2; ++bj) {
                    const int g32 = u.pn * 8 + bj * 4 + wc;
                    const int rope = (isq && lat && (g32 % 3 == 2)) ? 1 : 0;
                    f32x4 v0 = acc[ai][bj][m][0] * rs, v1 = acc[ai][bj][m][1] * rs;
                    if (rope) rope_apply(v0, v1, 1, row, wc, fq, tabM, tabM);
                    store_bf16x8(O + (size_t)row * ldo + g32 * 32 + 8 * fq, v0, v1);
                }
            }
    }
};
struct EpiRes {
    const float* srcL; const float* srcC; float* dstL; float* dstC; const float* gate; const float* bias; const float* stat;
    __device__ __forceinline__ void operator()(const f32x4 (&acc)[2][2][4][2], const Unit& u, int wr_in, int wc_in, int fr_in, int fq_in) const {
        int fr = fr_in, fq = fq_in, wr = wr_in, wc = wc_in; asm volatile("" : "+v"(fr), "+v"(fq), "+s"(wr), "+s"(wc));
        const bool lat = u.pm < 128;
        const int b = lat ? (u.pm >> 3) : 16;
        const float* gp = gate + (size_t)b * 6144;
        const float* src = lat ? srcL : srcC; float* dst = lat ? dstL : dstC;
        const int rbase = (lat ? u.pm : (u.pm - 128)) * 256 + wr * 64 + 4 * fr;
        const int colw = u.pn * 256 + wc * 32 + 8 * fq;
#pragma unroll
        for (int ai = 0; ai < 2; ++ai) {
            float sa[4], sb[4];
#pragma unroll
            for (int m = 0; m < 4; ++m) { sa[m] = ALPHA; sb[m] = 0.f;
                if (stat) { const float2 st = *(const float2*)(stat + 2 * (size_t)(u.pm * 256 + wr * 64 + 4 * fr + ai * 128 + m)); sa[m] = ALPHA * st.y; sb[m] = -sa[m] * st.x; } }
#pragma unroll
            for (int bj = 0; bj < 2; ++bj) {
                const int col0 = colw + bj * 128;
                f32x4 x[4][2];
#pragma unroll
                for (int m = 0; m < 4; ++m) { const float* p = src + (size_t)(rbase + ai * 128 + m) * DM + col0; x[m][0] = *(const f32x4*)(p); x[m][1] = *(const f32x4*)(p + 4); }
                const f32x4 g0 = *(const f32x4*)(gp + col0), g1 = *(const f32x4*)(gp + col0 + 4);
                f32x4 b0 = (f32x4){0.f, 0.f, 0.f, 0.f}, b1 = b0;
                if (bias) { b0 = *(const f32x4*)(bias + col0); b1 = *(const f32x4*)(bias + col0 + 4); }
#pragma unroll
                for (int m = 0; m < 4; ++m) {
                    float* q = dst + (size_t)(rbase + ai * 128 + m) * DM + col0;
                    const f32x4 r0 = x[m][0] * sa[m] + sb[m] + g0 * (acc[ai][bj][m][0] + b0), r1 = x[m][1] * sa[m] + sb[m] + g1 * (acc[ai][bj][m][1] + b1);
                    *(f32x4*)(q) = r0; *(f32x4*)(q + 4) = r1;
                }
                __builtin_amdgcn_sched_barrier(0);
            }
        }
    }
};
__device__ __forceinline__ float dpp_shr1(float v) { return __builtin_bit_cast(float, __builtin_amdgcn_update_dpp(0, __builtin_bit_cast(int, v), 0x111, 0xf, 0xf, true)); }
__device__ __forceinline__ float dpp_shl1(float v) { return __builtin_bit_cast(float, __builtin_amdgcn_update_dpp(0, __builtin_bit_cast(int, v), 0x101, 0xf, 0xf, true)); }
struct EpiUp {
    bf16_t* G; float* halo; const float* b_up; const float* conv_w; const float* conv_b; LAS float* pl;
    __device__ __forceinline__ void operator()(const f32x4 (&acc)[2][2][4][2], const Unit& u, int wr_in, int wc_in, int fr_in, int fq_in) const {
        typedef float f32x2 __attribute__((ext_vector_type(2)));
        int fr = fr_in, fq = fq_in, wr = wr_in, wc = wc_in; asm volatile("" : "+v"(fr), "+v"(fq), "+s"(wr), "+s"(wc));
        const int lane = fq * 16 + fr;
        const int cw0 = u.pn * 128 + wc * 32;
        const int ca0 = cw0 + 8 * fq;
        const int tcol0 = u.pn * 256 + wc * 32 + 8 * fq;
        LAS float* P = pl + (wr * 4 + wc) * 320;
        {
#pragma unroll
            for (int k = 0; k < 5; ++k) { const int idx = lane + 64 * k, p = idx >> 5, c = idx & 31; const int col = cw0 + c + (p >= 5 ? FFH : 0); const int pp = p >= 5 ? p - 5 : p;
                const float v = (pp == 0) ? b_up[col] : (pp == 4) ? conv_b[col] : conv_w[(size_t)(pp - 1) * FF2 + col];
                P[idx] = v; }
        }
#pragma unroll
        for (int ai = 0; ai < 2; ++ai) {
            if (fr == 0 || fr == 15) {
                const int g64 = u.pm * 4 + ai * 2 + wr;
                float* hp = halo + ((size_t)(g64 * 4 + (fr ? 2 : 0))) * FF2 + tcol0;
#pragma unroll
                for (int n = 0; n < 2; ++n) {
                    const f32x4 bua = *(const LAS f32x4*)(P + 8 * fq + 4 * n), bug = *(const LAS f32x4*)(P + 160 + 8 * fq + 4 * n);
                    const f32x4 a0 = fr ? acc[ai][0][2][n] : acc[ai][0][0][n], a1 = fr ? acc[ai][0][3][n] : acc[ai][0][1][n];
                    const f32x4 g0 = fr ? acc[ai][1][2][n] : acc[ai][1][0][n], g1 = fr ? acc[ai][1][3][n] : acc[ai][1][1][n];
                    *(f32x4*)(hp + 4 * n) = a0 + bua; *(f32x4*)(hp + 128 + 4 * n) = g0 + bug;
                    *(f32x4*)(hp + FF2 + 4 * n) = a1 + bua; *(f32x4*)(hp + FF2 + 128 + 4 * n) = g1 + bug;
                }
            }
            u32x4 pk[4];
#pragma unroll
            for (int n = 0; n < 2; ++n)
#pragma unroll
                for (int ep = 0; ep < 2; ++ep) {
                    const int e0 = 2 * ep; const LAS float* pc = P + 8 * fq + 4 * n + e0;
                    const f32x2 bua = *(const LAS f32x2*)(pc), w0a = *(const LAS f32x2*)(pc + 32), w1a = *(const LAS f32x2*)(pc + 64), w2a = *(const LAS f32x2*)(pc + 96), cba = *(const LAS f32x2*)(pc + 128);
                    const f32x2 bug = *(const LAS f32x2*)(pc + 160), w0g = *(const LAS f32x2*)(pc + 192), w1g = *(const LAS f32x2*)(pc + 224), w2g = *(const LAS f32x2*)(pc + 256), cbg = *(const LAS f32x2*)(pc + 288);
                    f32x2 av[4];
                    {
                        f32x2 x[4], pv, nv;
#pragma unroll
                        for (int m = 0; m < 4; ++m) { x[m].x = acc[ai][0][m][n][e0]; x[m].y = acc[ai][0][m][n][e0 + 1]; x[m] = x[m] + bua; }
                        pv.x = dpp_shr1(x[3].x); pv.y = dpp_shr1(x[3].y); nv.x = dpp_shl1(x[0].x); nv.y = dpp_shl1(x[0].y);
                        av[0] = w0a * pv + w1a * x[0] + w2a * x[1] + cba;
                        av[1] = w0a * x[0] + w1a * x[1] + w2a * x[2] + cba;
                        av[2] = w0a * x[1] + w1a * x[2] + w2a * x[3] + cba;
                        av[3] = w0a * x[2] + w1a * x[3] + w2a * nv + cba;
                    }
                    {
                        f32x2 x[4], pv, nv, gv[4];
#pragma unroll
                        for (int m = 0; m < 4; ++m) { x[m].x = acc[ai][1][m][n][e0]; x[m].y = acc[ai][1][m][n][e0 + 1]; x[m] = x[m] + bug; }
                        pv.x = dpp_shr1(x[3].x); pv.y = dpp_shr1(x[3].y); nv.x = dpp_shl1(x[0].x); nv.y = dpp_shl1(x[0].y);
                        gv[0] = w0g * pv + w1g * x[0] + w2g * x[1] + cbg;
                        gv[1] = w0g * x[0] + w1g * x[1] + w2g * x[2] + cbg;
                        gv[2] = w0g * x[1] + w1g * x[2] + w2g * x[3] + cbg;
                        gv[3] = w0g * x[2] + w1g * x[3] + w2g * nv + cbg;
#pragma unroll
                        for (int m = 0; m < 4; ++m) {
                            const f32x2 t = gv[m] * (-LOG2E);
                            f32x2 sg; sg.x = __builtin_amdgcn_rcpf(1.0f + __builtin_amdgcn_exp2f(t.x)); sg.y = __builtin_amdgcn_rcpf(1.0f + __builtin_amdgcn_exp2f(t.y));
                            const f32x2 ov = av[m] * gv[m] * sg;
                            pk[m][2 * n + ep] = cvt_pk_bf16(ov.x, ov.y); }
                    }
                    __builtin_amdgcn_sched_barrier(0);
                }
            bf16_t* gp = G + (size_t)(u.pm * 256 + ai * 128 + wr * 64 + 4 * fr) * FFH + ca0;
            if (fr != 0) *(u32x4*)(gp) = pk[0];
            *(u32x4*)(gp + FFH) = pk[1];
            *(u32x4*)(gp + 2 * FFH) = pk[2];
            if (fr != 15) *(u32x4*)(gp + 3 * FFH) = pk[3];
        }
    }
};

struct AttnDesc {
    const bf16_t* q; int ldq;
    bf16_t* o; int ldo;
    const bf16_t* k; int ldk;
    const bf16_t* kr; int ldkr;
    const bf16_t* v; int ldv;
    int nloc, loc_row0, ctx_row0;
    int mode;
    int a0, a1, a2;
    float sink;
};
constexpr int ATT_KBUF = 64 * 208, ATT_VOFF = 2 * ATT_KBUF, ATT_RPB = ATT_VOFF + 2 * 8192;
constexpr int ATT2_KSTG = 2 * ATT_KBUF, ATT2_VOFF = 2 * ATT2_KSTG, ATT2_VSTG = 2 * 8192;

__device__ __forceinline__ void attn_unit_mla(LAS unsigned char* lds, const AttnDesc& A, int tid, int wid, int lane) {
    constexpr int KSTR = (96 + 8) * 2, NS = 6;
    const int r32 = lane & 31, h = lane >> 5;
    const int nt = A.nloc + 4, nstg = nt >> 1;
    bf16x8 qf[NS];
#pragma unroll
    for (int s = 0; s < NS; ++s) qf[s] = *(const bf16x8*)(A.q + (size_t)r32 * A.ldq + 16 * s + 8 * h);
    f32x16 o0, o1;
#pragma unroll
    for (int r = 0; r < 16; ++r) { o0[r] = 0.f; o1[r] = 0.f; }
    float mrun = -1e30f, lrun = 0.f;
    const int skey = tid >> 3, sch = tid & 7;
    u32x4 ka, va, kra = (u32x4){0u, 0u, 0u, 0u}, kb_, vb_, krb = (u32x4){0u, 0u, 0u, 0u};
#define MLA_LOAD(KR, VR, KRR, tt) do { const int t1_ = (tt); const int row0_ = (t1_ < A.nloc) ? A.loc_row0 + 64 * t1_ : A.ctx_row0 + 64 * (t1_ - A.nloc); \
        KR = *(const u32x4*)(A.k + (size_t)(row0_ + skey) * A.ldk + 8 * sch); VR = *(const u32x4*)(A.v + (size_t)(row0_ + skey) * A.ldv + 8 * sch); \
        if (tid < 256) KRR = *(const u32x4*)(A.kr + (size_t)(row0_ + (tid >> 2)) * A.ldkr + 8 * (tid & 3)); } while (0)
#define MLA_STORE(KR, VR, KRR, kbp, vbp) do { *(LAS u32x4*)((kbp) + skey * KSTR + sch * 16) = KR; \
        if (tid < 256) *(LAS u32x4*)((kbp) + (tid >> 2) * KSTR + 128 + (tid & 3) * 16) = KRR; \
        *(LAS u32x4*)((vbp) + (sch >> 2) * 4096 + skey * 64 + (sch & 3) * 16) = VR; } while (0)
    MLA_LOAD(ka, va, kra, 0); MLA_LOAD(kb_, vb_, krb, 1);
    const int vtr_off = ((lane & 15) >> 2) * 64 + (16 * ((lane >> 4) & 1) + 4 * (lane & 3)) * 2 + 4 * h * 64;
    for (int st = 0; st < nstg; ++st) {
        LAS unsigned char* kbuf = lds + (st & 1) * ATT2_KSTG;
        LAS unsigned char* vbuf = lds + ATT2_VOFF + (st & 1) * ATT2_VSTG;
        MLA_STORE(ka, va, kra, kbuf, vbuf); MLA_STORE(kb_, vb_, krb, kbuf + ATT_KBUF, vbuf + 8192);
        __syncthreads();
        if (st + 1 < nstg) { MLA_LOAD(ka, va, kra, 2 * st + 2); MLA_LOAD(kb_, vb_, krb, 2 * st + 3); }
        f32x16 s0, s1, s2, s3;
#pragma unroll
        for (int r = 0; r < 16; ++r) { s0[r] = 0.f; s1[r] = 0.f; s2[r] = 0.f; s3[r] = 0.f; }
#pragma unroll
        for (int s = 0; s < NS; ++s) {
            const int co = (16 * s + 8 * h) * 2;
            const bf16x8 k0 = *(const LAS bf16x8*)(kbuf + r32 * KSTR + co);
            const bf16x8 k1 = *(const LAS bf16x8*)(kbuf + (32 + r32) * KSTR + co);
            const bf16x8 k2 = *(const LAS bf16x8*)(kbuf + ATT_KBUF + r32 * KSTR + co);
            const bf16x8 k3 = *(const LAS bf16x8*)(kbuf + ATT_KBUF + (32 + r32) * KSTR + co);
            s0 = __builtin_amdgcn_mfma_f32_32x32x16_bf16(k0, qf[s], s0, 0, 0, 0);
            s1 = __builtin_amdgcn_mfma_f32_32x32x16_bf16(k1, qf[s], s1, 0, 0, 0);
            s2 = __builtin_amdgcn_mfma_f32_32x32x16_bf16(k2, qf[s], s2, 0, 0, 0);
            s3 = __builtin_amdgcn_mfma_f32_32x32x16_bf16(k3, qf[s], s3, 0, 0, 0);
        }
        float m0 = fmaxf(fmaxf(s0[0], s1[0]), fmaxf(s2[0], s3[0]));
#pragma unroll
        for (int r = 1; r < 16; ++r) { m0 = fmaxf(fmaxf(m0, s0[r]), s1[r]); m0 = fmaxf(fmaxf(m0, s2[r]), s3[r]); }
        float mx = fmaxf(m0, __shfl_xor(m0, 32));
        if (__builtin_amdgcn_ballot_w64(mx > mrun + 8.0f) != 0ull) {
            const float mnew = fmaxf(mrun, mx);
            const float alpha = __builtin_amdgcn_exp2f(mrun - mnew);
            mrun = mnew; lrun *= alpha;
#pragma unroll
            for (int r = 0; r < 16; ++r) { o0[r] *= alpha; o1[r] *= alpha; }
        }
        float ra = 0.f, rb = 0.f;
#pragma unroll
        for (int r = 0; r < 16; ++r) { s0[r] = __builtin_amdgcn_exp2f(s0[r] - mrun); s1[r] = __builtin_amdgcn_exp2f(s1[r] - mrun); s2[r] = __builtin_amdgcn_exp2f(s2[r] - mrun); s3[r] = __builtin_amdgcn_exp2f(s3[r] - mrun);
            ra += s0[r] + s1[r]; rb += s2[r] + s3[r]; }
        lrun += ra + rb;
#define MLA_PACK(S, q) __builtin_bit_cast(bf16x8, (u32x4){cvt_pk_bf16_m(S[8 * (q) + 0], S[8 * (q) + 1]), cvt_pk_bf16_m(S[8 * (q) + 2], S[8 * (q) + 3]), cvt_pk_bf16_m(S[8 * (q) + 4], S[8 * (q) + 5]), cvt_pk_bf16_m(S[8 * (q) + 6], S[8 * (q) + 7])})
#define MLA_PV(PF, vbp, ks) do { const LAS unsigned char* vp = (vbp) + vtr_off + (ks) * 16 * 64; \
            const s16x4 a0 = __builtin_bit_cast(s16x4, __builtin_amdgcn_ds_read_tr16_b64_v4i16((LAS s16x4*)(vp))); \
            const s16x4 a1 = __builtin_bit_cast(s16x4, __builtin_amdgcn_ds_read_tr16_b64_v4i16((LAS s16x4*)(vp + 8 * 64))); \
            const s16x4 c0 = __builtin_bit_cast(s16x4, __builtin_amdgcn_ds_read_tr16_b64_v4i16((LAS s16x4*)(vp + 4096))); \
            const s16x4 c1 = __builtin_bit_cast(s16x4, __builtin_amdgcn_ds_read_tr16_b64_v4i16((LAS s16x4*)(vp + 4096 + 8 * 64))); \
            const bf16x8 va_ = (bf16x8){a0[0], a0[1], a0[2], a0[3], a1[0], a1[1], a1[2], a1[3]}; \
            const bf16x8 vc_ = (bf16x8){c0[0], c0[1], c0[2], c0[3], c1[0], c1[1], c1[2], c1[3]}; \
            o0 = __builtin_amdgcn_mfma_f32_32x32x16_bf16(va_, PF, o0, 0, 0, 0); o1 = __builtin_amdgcn_mfma_f32_32x32x16_bf16(vc_, PF, o1, 0, 0, 0); } while (0)
        { const bf16x8 p = MLA_PACK(s0, 0); MLA_PV(p, vbuf, 0); }
        { const bf16x8 p = MLA_PACK(s0, 1); MLA_PV(p, vbuf, 1); }
        { const bf16x8 p = MLA_PACK(s1, 0); MLA_PV(p, vbuf, 2); }
        { const bf16x8 p = MLA_PACK(s1, 1); MLA_PV(p, vbuf, 3); }
        { const bf16x8 p = MLA_PACK(s2, 0); MLA_PV(p, vbuf + 8192, 0); }
        { const bf16x8 p = MLA_PACK(s2, 1); MLA_PV(p, vbuf + 8192, 1); }
        { const bf16x8 p = MLA_PACK(s3, 0); MLA_PV(p, vbuf + 8192, 2); }
        { const bf16x8 p = MLA_PACK(s3, 1); MLA_PV(p, vbuf + 8192, 3); }
    }
#undef MLA_LOAD
#undef MLA_STORE
#undef MLA_PACK
#undef MLA_PV
    const float ltot = lrun + __shfl_xor(lrun, 32);
    const float inv = 1.0f / ltot;
    bf16_t* op = A.o + (size_t)r32 * A.ldo + 4 * h;
#pragma unroll
    for (int g4 = 0; g4 < 4; ++g4) {
        u32x2 w;
        w.x = cvt_pk_bf16_m(o0[4 * g4 + 0] * inv, o0[4 * g4 + 1] * inv); w.y = cvt_pk_bf16_m(o0[4 * g4 + 2] * inv, o0[4 * g4 + 3] * inv);
        *(u32x2*)(op + 8 * g4) = w;
        w.x = cvt_pk_bf16_m(o1[4 * g4 + 0] * inv, o1[4 * g4 + 1] * inv); w.y = cvt_pk_bf16_m(o1[4 * g4 + 2] * inv, o1[4 * g4 + 3] * inv);
        *(u32x2*)(op + 32 + 8 * g4) = w;
    }
    __syncthreads();
}

template <int DQ>
__device__ __forceinline__ void attn_unit(LAS unsigned char* lds, const AttnDesc& A, int tid, int wid, int lane) {
    constexpr int KSTR = (DQ + 8) * 2, NS = DQ / 16;
    const int r32 = lane & 31, h = lane >> 5;
    const int nt = A.nloc + 4;
    bf16x8 qf[NS];
#pragma unroll
    for (int s = 0; s < NS; ++s) qf[s] = *(const bf16x8*)(A.q + (size_t)r32 * A.ldq + 16 * s + 8 * h);
    f32x16 o0, o1;
#pragma unroll
    for (int r = 0; r < 16; ++r) { o0[r] = 0.f; o1[r] = 0.f; }
    float mrun = -1e30f, lrun = 0.f;
    f32x16 zero16;
#pragma unroll
    for (int r = 0; r < 16; ++r) zero16[r] = 0.f;
    asm volatile("" : "+v"(zero16));
    const int skey = tid >> 3, sch = tid & 7;
    u32x4 kreg, vreg, krreg = (u32x4){0u, 0u, 0u, 0u};
    {
        const int row0 = (0 < A.nloc) ? A.loc_row0 : A.ctx_row0;
        kreg = *(const u32x4*)(A.k + (size_t)(row0 + skey) * A.ldk + 8 * sch);
        vreg = *(const u32x4*)(A.v + (size_t)(row0 + skey) * A.ldv + 8 * sch);
        if (DQ == 96 && tid < 256) krreg = *(const u32x4*)(A.kr + (size_t)(row0 + (tid >> 2)) * A.ldkr + 8 * (tid & 3));
    }
    const LAS float* rpbl = (const LAS float*)(lds + ATT_RPB);
    const int vtr_off = ((lane & 15) >> 2) * 64 + (16 * ((lane >> 4) & 1) + 4 * (lane & 3)) * 2 + 4 * h * 64;
    for (int t = 0; t < nt; ++t) {
        LAS unsigned char* kb = lds + (t & 1) * ATT_KBUF;
        LAS unsigned char* vb = lds + ATT_VOFF + (t & 1) * 8192;
        *(LAS u32x4*)(kb + skey * KSTR + sch * 16) = kreg;
        if (DQ == 96 && tid < 256) *(LAS u32x4*)(kb + (tid >> 2) * KSTR + 128 + (tid & 3) * 16) = krreg;
        *(LAS u32x4*)(vb + (sch >> 2) * 4096 + skey * 64 + (sch & 3) * 16) = vreg;
        __syncthreads();
        if (t + 1 < nt) {
            const int t1 = t + 1;
            const int row0 = (t1 < A.nloc) ? A.loc_row0 + 64 * t1 : A.ctx_row0 + 64 * (t1 - A.nloc);
            kreg = *(const u32x4*)(A.k + (size_t)(row0 + skey) * A.ldk + 8 * sch);
            vreg = *(const u32x4*)(A.v + (size_t)(row0 + skey) * A.ldv + 8 * sch);
            if (DQ == 96 && tid < 256) krreg = *(const u32x4*)(A.kr + (size_t)(row0 + (tid >> 2)) * A.ldkr + 8 * (tid & 3));
        }
        const bool loc = t < A.nloc;
        bool act = true;
        if (A.mode == 1 && loc) { const int kr = A.a0 + t; act = (kr >= A.a2) && (kr < A.a2 + 8); }
        if (act) {
            f32x16 s0, s1;
#pragma unroll
            for (int s = 0; s < NS; ++s) {
                const bf16x8 k0 = *(const LAS bf16x8*)(kb + r32 * KSTR + (16 * s + 8 * h) * 2);
                const bf16x8 k1 = *(const LAS bf16x8*)(kb + (32 + r32) * KSTR + (16 * s + 8 * h) * 2);
                s0 = __builtin_amdgcn_mfma_f32_32x32x16_bf16(k0, qf[s], s == 0 ? zero16 : s0, 0, 0, 0);
                s1 = __builtin_amdgcn_mfma_f32_32x32x16_bf16(k1, qf[s], s == 0 ? zero16 : s1, 0, 0, 0);
            }
            if (loc && A.mode == 1) {
                const int qc = 32 * (wid & 1) + r32;
                const int w0 = min(max(qc - 8, 0), 48);
                const int rbase = (A.a0 + t - A.a1 + 7) * 31;
#pragma unroll
                for (int r = 0; r < 16; ++r) {
                    const int kc = (r & 3) + 8 * (r >> 2) + 4 * h;
                    { const int dc = min(max(kc - qc + 15, 0), 30); const bool ok = (unsigned)(kc - w0) < 16u; const float bv = rpbl[rbase + dc]; s0[r] = ok ? s0[r] + bv : -1e30f; }
                    { const int kc2 = kc + 32; const int dc = min(max(kc2 - qc + 15, 0), 30); const bool ok = (unsigned)(kc2 - w0) < 16u; const float bv = rpbl[rbase + dc]; s1[r] = ok ? s1[r] + bv : -1e30f; }
                }
            } else if (loc && A.mode == 2) {
                const int p0 = A.a0 + 64 * t;
                if (p0 < A.a1 + 31 - 128 || p0 + 63 > A.a1 + 128) {
                    const int dbase = p0 - (A.a1 + r32);
#pragma unroll
                    for (int r = 0; r < 16; ++r) {
                        const int kc = (r & 3) + 8 * (r >> 2) + 4 * h;
                        s0[r] = ((unsigned)(dbase + kc + 128) > 256u) ? -1e30f : s0[r];
                        s1[r] = ((unsigned)(dbase + kc + 32 + 128) > 256u) ? -1e30f : s1[r];
                    }
                }
            }
            float mxa = fmaxf(fmaxf(s0[0], s0[1]), s0[2]), mxb = fmaxf(fmaxf(s1[0], s1[1]), s1[2]);
            mxa = fmaxf(fmaxf(mxa, s0[3]), s0[4]); mxb = fmaxf(fmaxf(mxb, s1[3]), s1[4]);
            mxa = fmaxf(fmaxf(mxa, s0[5]), s0[6]); mxb = fmaxf(fmaxf(mxb, s1[5]), s1[6]);
            mxa = fmaxf(fmaxf(mxa, s0[7]), s0[8]); mxb = fmaxf(fmaxf(mxb, s1[7]), s1[8]);
            mxa = fmaxf(fmaxf(mxa, s0[9]), s0[10]); mxb = fmaxf(fmaxf(mxb, s1[9]), s1[10]);
            mxa = fmaxf(fmaxf(mxa, s0[11]), s0[12]); mxb = fmaxf(fmaxf(mxb, s1[11]), s1[12]);
            mxa = fmaxf(fmaxf(mxa, s0[13]), s0[14]); mxb = fmaxf(fmaxf(mxb, s1[13]), s1[14]);
            float mx = fmaxf(fmaxf(mxa, mxb), fmaxf(s0[15], s1[15]));
            mx = fmaxf(mx, __shfl_xor(mx, 32));
            if (__builtin_amdgcn_ballot_w64(mx > mrun + 8.0f) != 0ull) {
                const float mnew = fmaxf(mrun, mx);
                const float alpha = __builtin_amdgcn_exp2f(mrun - mnew);
                mrun = mnew; lrun *= alpha;
#pragma unroll
                for (int r = 0; r < 16; ++r) { o0[r] *= alpha; o1[r] *= alpha; }
            }
            float rsa = 0.f, rsb = 0.f;
#pragma unroll
            for (int r = 0; r < 16; ++r) { s0[r] = __builtin_amdgcn_exp2f(s0[r] - mrun); s1[r] = __builtin_amdgcn_exp2f(s1[r] - mrun); rsa += s0[r]; rsb += s1[r]; }
            lrun += rsa + rsb;
            bf16x8 pf[4];
#pragma unroll
            for (int s2 = 0; s2 < 2; ++s2) {
                u32x4 w;
                w.x = cvt_pk_bf16_m(s0[8 * s2 + 0], s0[8 * s2 + 1]); w.y = cvt_pk_bf16_m(s0[8 * s2 + 2], s0[8 * s2 + 3]); w.z = cvt_pk_bf16_m(s0[8 * s2 + 4], s0[8 * s2 + 5]); w.w = cvt_pk_bf16_m(s0[8 * s2 + 6], s0[8 * s2 + 7]);
                pf[s2] = __builtin_bit_cast(bf16x8, w);
                w.x = cvt_pk_bf16_m(s1[8 * s2 + 0], s1[8 * s2 + 1]); w.y = cvt_pk_bf16_m(s1[8 * s2 + 2], s1[8 * s2 + 3]); w.z = cvt_pk_bf16_m(s1[8 * s2 + 4], s1[8 * s2 + 5]); w.w = cvt_pk_bf16_m(s1[8 * s2 + 6], s1[8 * s2 + 7]);
                pf[2 + s2] = __builtin_bit_cast(bf16x8, w);
            }
#pragma unroll
            for (int ks = 0; ks < 4; ++ks) {
                const LAS unsigned char* vp = vb + vtr_off + ks * 16 * 64;
                const s16x4 a0 = __builtin_bit_cast(s16x4, __builtin_amdgcn_ds_read_tr16_b64_v4i16((LAS s16x4*)(vp)));
                const s16x4 a1 = __builtin_bit_cast(s16x4, __builtin_amdgcn_ds_read_tr16_b64_v4i16((LAS s16x4*)(vp + 8 * 64)));
                const s16x4 c0 = __builtin_bit_cast(s16x4, __builtin_amdgcn_ds_read_tr16_b64_v4i16((LAS s16x4*)(vp + 4096)));
                const s16x4 c1 = __builtin_bit_cast(s16x4, __builtin_amdgcn_ds_read_tr16_b64_v4i16((LAS s16x4*)(vp + 4096 + 8 * 64)));
                const bf16x8 va = (bf16x8){a0[0], a0[1], a0[2], a0[3], a1[0], a1[1], a1[2], a1[3]};
                const bf16x8 vc = (bf16x8){c0[0], c0[1], c0[2], c0[3], c1[0], c1[1], c1[2], c1[3]};
                o0 = __builtin_amdgcn_mfma_f32_32x32x16_bf16(va, pf[ks], o0, 0, 0, 0);
                o1 = __builtin_amdgcn_mfma_f32_32x32x16_bf16(vc, pf[ks], o1, 0, 0, 0);
            }
        }
    }
    float ltot = lrun + __shfl_xor(lrun, 32);
    ltot += __builtin_amdgcn_exp2f(A.sink - mrun);
    const float inv = 1.0f / ltot;
    bf16_t* op = A.o + (size_t)r32 * A.ldo + 4 * h;
#pragma unroll
    for (int g4 = 0; g4 < 4; ++g4) {
        u32x2 w;
        w.x = cvt_pk_bf16_m(o0[4 * g4 + 0] * inv, o0[4 * g4 + 1] * inv); w.y = cvt_pk_bf16_m(o0[4 * g4 + 2] * inv, o0[4 * g4 + 3] * inv);
        *(u32x2*)(op + 8 * g4) = w;
        w.x = cvt_pk_bf16_m(o1[4 * g4 + 0] * inv, o1[4 * g4 + 1] * inv); w.y = cvt_pk_bf16_m(o1[4 * g4 + 2] * inv, o1[4 * g4 + 3] * inv);
        *(u32x2*)(op + 32 + 8 * g4) = w;
    }
    __syncthreads();
}


#define XB_TMO      128
#define XB_XCNT(j)  (256  + 64 * (j))
#define XB_XSUB(j)  (1280 + 64 * (j))
#define XB_XGEN(j)  (2304 + 64 * (j))
#define XB_TOP      3328
#define XB_TOPGEN   3392
#define XCD_BAR_WORDS 3456
#define XB_SPIN_CAP (1u << 18)
__device__ __forceinline__ unsigned xb_ld(unsigned* p)              { return __hip_atomic_load(p, __ATOMIC_RELAXED, __HIP_MEMORY_SCOPE_AGENT); }
__device__ __forceinline__ unsigned xb_add(unsigned* p, unsigned v) { return __hip_atomic_fetch_add(p, v, __ATOMIC_RELAXED, __HIP_MEMORY_SCOPE_AGENT); }
__device__ __forceinline__ unsigned xb_xcc_id() { return (unsigned)__builtin_amdgcn_s_getreg((3 << 11) | 20) & 0xFu; }
#define XB_SPIN(cond, bar) do { unsigned _sp = 0; while (cond) { __builtin_amdgcn_s_sleep(1); \
    if ((++_sp & 255u) == 0u) { if (xb_ld(&(bar)[XB_TMO])) break; if (_sp > XB_SPIN_CAP) { atomicAdd(&(bar)[XB_TMO], 1u); break; } } } } while (0)
struct XcdBarrier { unsigned* bar; unsigned x; volatile LAS unsigned* st; };
__device__ __forceinline__ XcdBarrier xcd_barrier_post(unsigned* bar, volatile LAS unsigned* st) {
    XcdBarrier b; b.bar = bar; b.x = xb_xcc_id(); b.st = st;
    if (threadIdx.x == 0) (void)xb_add(&bar[XB_XCNT(b.x)], 1u);
    return b;
}
__device__ __forceinline__ void xcd_barrier_complete(unsigned* bar, unsigned x, unsigned& nloc, unsigned& nx) {
    const unsigned G = gridDim.x * gridDim.y * gridDim.z;
    unsigned sum, cnt, mine, sp = 0u;
    for (;;) {
        sum = 0u; cnt = 0u; mine = 0u;
#pragma unroll
        for (unsigned j = 0; j < 16; ++j) { const unsigned c = xb_ld(&bar[XB_XCNT(j)]); sum += c; cnt += (c > 0u) ? 1u : 0u; mine = (j == x) ? c : mine; }
        if (sum == G) break;
        __builtin_amdgcn_s_sleep(1);
        if ((++sp & 255u) == 0u) { if (xb_ld(&bar[XB_TMO])) break; if (sp > XB_SPIN_CAP) { atomicAdd(&bar[XB_TMO], 1u); break; } }
    }
    nloc = mine > 0u ? mine : 1u; nx = cnt > 0u ? cnt : 1u;
}
__device__ __forceinline__ void xcd_barrier(const XcdBarrier& b) {
    asm volatile("s_waitcnt vmcnt(0)" ::: "memory");
    __syncthreads();
    if (threadIdx.x == 0) {
        unsigned* bar = b.bar;
        __builtin_amdgcn_s_waitcnt(0);
        unsigned nloc = b.st[0], nx = b.st[1];
        if (nloc == 0u) { xcd_barrier_complete(bar, b.x, nloc, nx); b.st[0] = nloc; b.st[1] = nx; }
        const unsigned old = xb_add(&bar[XB_XSUB(b.x)], 1u);
        const unsigned gen = old / nloc;
        if (old + 1u == (gen + 1u) * nloc) {
            __builtin_amdgcn_fence(__ATOMIC_RELEASE, "agent");
            asm volatile("s_waitcnt vmcnt(0)" ::: "memory");
            const unsigned og = xb_add(&bar[XB_TOP], 1u);
            const unsigned tg = og / nx;
            if (og + 1u == (tg + 1u) * nx) xb_add(&bar[XB_TOPGEN], 1u);
            else XB_SPIN(xb_ld(&bar[XB_TOPGEN]) == tg, bar);
            __builtin_amdgcn_fence(__ATOMIC_ACQUIRE, "agent");
            xb_add(&bar[XB_XGEN(b.x)], 1u);
            asm volatile("s_waitcnt vmcnt(0)" ::: "memory");
        } else {
            XB_SPIN(xb_ld(&bar[XB_XGEN(b.x)]) == gen, bar);
            __builtin_amdgcn_fence(__ATOMIC_ACQUIRE, "agent");
            asm volatile("s_waitcnt vmcnt(0)" ::: "memory");
        }
    }
    __syncthreads();
}
constexpr int LDS_BARST = 131072 + 10240;

struct Args { const float* in[22]; float* out; unsigned char* ws; int ph_lo, ph_hi; };
enum { IN_X = 0, IN_C, IN_CTX, IN_CCTX, IN_WADA, IN_BADA, IN_RPB, IN_WINE, IN_QNORM, IN_WUQ, IN_KVNORM, IN_WUKV, IN_WOUTE, IN_WINO, IN_SINKS, IN_WOUTO, IN_WUP, IN_BUP, IN_CONVW, IN_CONVB, IN_WDOWN, IN_BDOWN };
constexpr int N_PHASES = 2 + 11 + 10 + 11 + 8;

__device__ __forceinline__ float wave_sum(float v) {
#pragma unroll
    for (int o = 1; o < 64; o <<= 1) v += __shfl_xor(v, o);
    return v;
}

__device__ __forceinline__ void conv_item(const float* W, int K, int N, int Np, bf16_t* WT, const float* kscale, int mapmode, LAS float* scr, int item, int lane) {
    const int nblk = Np / 64, kb = item / nblk, nb = item % nblk, k0 = 64 * kb, n0 = 64 * nb;
    int src0 = n0;
    if (mapmode == 1) { const int tl = n0 >> 8, i = n0 & 255; src0 = (i < 128) ? (128 * tl + i) : (FFH + 128 * tl + (i - 128)); }
    const int c4 = 4 * (lane & 15);
    const bool valid = (mapmode == 1) || (n0 + c4 < N);
#pragma unroll 8
    for (int j = 0; j < 16; ++j) { const int kk = 4 * j + (lane >> 4);
        f32x4 v = (f32x4){0.f, 0.f, 0.f, 0.f};
        if (valid) { v = *(const f32x4*)(W + (size_t)(k0 + kk) * N + src0 + c4); if (kscale) v = v * kscale[k0 + kk]; }
        LAS float* d = scr + kk * 65 + c4; d[0] = v[0]; d[1] = v[1]; d[2] = v[2]; d[3] = v[3]; }
    const int c = lane & 7;
#pragma unroll
    for (int j = 0; j < 8; ++j) { const int n = (lane >> 3) + 8 * j; const LAS float* sp = scr + (8 * c) * 65 + n;
        u32x4 o; o.x = cvt_pk_bf16(sp[0 * 65], sp[1 * 65]); o.y = cvt_pk_bf16(sp[2 * 65], sp[3 * 65]); o.z = cvt_pk_bf16(sp[4 * 65], sp[5 * 65]); o.w = cvt_pk_bf16(sp[6 * 65], sp[7 * 65]);
        *(u32x4*)(WT + (size_t)(n0 + n) * K + k0 + 8 * c) = o; }
}

__device__ __forceinline__ void sincos_d(double a, float& c, float& s) {
    const double twopi = 6.283185307179586476925;
    const double k = __builtin_rint(a / twopi);
    const double r = a - k * twopi;
    const double r2 = r * r;
    double cs = 1.0, sn = r, tc = 1.0, ts = r;
#pragma unroll 1
    for (int i = 1; i <= 14; ++i) { tc = -tc * r2 / (double)((2 * i - 1) * (2 * i)); ts = -ts * r2 / (double)((2 * i) * (2 * i + 1)); cs += tc; sn += ts; }
    c = (float)cs; s = (float)sn;
}

__global__ void __launch_bounds__(512, 2) mk_fwd(Args args) {
    extern __shared__ __attribute__((aligned(16))) unsigned char lds_raw[];
    LAS unsigned char* lds = (LAS unsigned char*)lds_raw;
    const int G = gridDim.x, NGW = G * 8;
    cg::grid_group grid = cg::this_grid();
    if (threadIdx.x == 0) { ((volatile LAS unsigned*)(lds + LDS_BARST))[0] = 0u; ((volatile LAS unsigned*)(lds + LDS_BARST))[1] = 0u; }
    __syncthreads();
    const XcdBarrier xbar = xcd_barrier_post((unsigned*)args.ws, (volatile LAS unsigned*)(lds + LDS_BARST));

    for (int ph = args.ph_lo; ph < args.ph_hi; ++ph) {
        unsigned char* ws = args.ws; asm volatile("" : "+s"(ws));
        float* MODS = (float*)(ws + WS_MODS);
        float* tabM = (float*)(ws + WS_TAB); float* tabS = tabM + 1024;
        float* XC = (float*)(ws + WS_XC); float* XL = args.out;
        bf16_t* WB = (bf16_t*)(ws + WS_W);
        bf16_t* HO = (bf16_t*)(ws + WS_HO);
        bf16_t* Z = (bf16_t*)(ws + WS_Z);
        bf16_t* Q2 = (bf16_t*)(ws + WS_Q2);
        bf16_t* KV2 = (bf16_t*)(ws + WS_KV2);
        bf16_t* GB = (bf16_t*)(ws + WS_G);
        float* HALO = (float*)(ws + WS_HALO);
        float* STAT = (float*)(ws + WS_STAT);
        float* SSQ = (float*)(ws + WS_SSQ);
        int l = 0, kind = 100 + ph;
        if (ph >= 2) {
            const unsigned long long SEQ_E = 0x0ull | (1ull << 4) | (2ull << 8) | (3ull << 12) | (4ull << 16) | (9ull << 20) | (5ull << 24) | (6ull << 28) | (7ull << 32) | (8ull << 36) | (10ull << 40);
            const unsigned long long SEQ_O = 0x0ull | (2ull << 4) | (3ull << 8) | (4ull << 12) | (9ull << 16) | (5ull << 20) | (6ull << 24) | (7ull << 28) | (8ull << 32) | (10ull << 36);
            const unsigned long long SEQ_L = 0x0ull | (2ull << 4) | (3ull << 8) | (4ull << 12) | (5ull << 16) | (6ull << 20) | (7ull << 24) | (8ull << 28);
            unsigned long long seq; int pos;
            if (ph < 13) { l = 0; seq = SEQ_E; pos = ph - 2; } else if (ph < 23) { l = 1; seq = SEQ_O; pos = ph - 13; } else if (ph < 34) { l = 2; seq = SEQ_E; pos = ph - 23; } else { l = 3; seq = SEQ_L; pos = ph - 34; }
            kind = (int)((seq >> (4 * pos)) & 15ull);
        }
        int cv_lo = 0, cv_hi = 0, cv_w = 0, cv_n = 1;
        if (ph == 0 && EN(100)) {
            GET_TID();
            for (int it = blockIdx.x; it < 768; it += G) {
                const int l = it / 192, col0 = (it % 192) * 32, d0 = wid * 128;
                LAS float* sc = (LAS float*)(lds + wid * 10240);
                for (int b = 0; b < 17; ++b)
#pragma unroll
                    for (int hh = 0; hh < 2; ++hh) { const int dd = lane + 64 * hh; const float x = (b < 16) ? args.in[IN_C][b * 1024 + d0 + dd] : args.in[IN_CCTX][d0 + dd]; sc[b * 128 + dd] = x / (1.0f + __expf(-x)); }
                float acc[17];
#pragma unroll
                for (int b = 0; b < 17; ++b) acc[b] = 0.f;
                const int hi = lane >> 5, cc = lane & 31;
                const float* wp = args.in[IN_WADA] + ((size_t)(l * 1024 + d0 + hi)) * 6144 + col0 + cc;
#pragma unroll 16
                for (int i = 0; i < 64; ++i) { const float w = wp[(size_t)(2 * i) * 6144];
#pragma unroll
                    for (int b = 0; b < 17; ++b) acc[b] += sc[b * 128 + 2 * i + hi] * w; }
                LAS float* red = (LAS float*)(lds + 81920);
#pragma unroll
                for (int b = 0; b < 17; ++b) { const float t = acc[b] + __shfl_xor(acc[b], 32); if (hi == 0) red[(wid * 17 + b) * 32 + cc] = t; }
                __syncthreads();
                for (int x = tid; x < 17 * 32; x += 512) { const int b = x >> 5, c2 = x & 31; float sm = args.in[IN_BADA][l * 6144 + col0 + c2];
#pragma unroll
                    for (int w = 0; w < 8; ++w) sm += red[(w * 17 + b) * 32 + c2];
                    MODS[(size_t)(l * 17 + b) * 6144 + col0 + c2] = sm; }
                __syncthreads();
            }
            if (blockIdx.x == G - 1) {
                for (int x = tid; x < 64 * 8 + 64 * 16; x += 512) {
                    const bool isM = x < 512; const int y = isM ? x : x - 512; const int nf = isM ? 8 : 16; const int pos = y / nf, f = y % nf;
                    const double base = isM ? 0.31622776601683794 : 0.5623413251903491;
                    double inv = 1.0; for (int i = 0; i < f; ++i) inv *= base;
                    const float ang = (float)pos * (float)inv;
                    float c, s; sincos_d((double)ang, c, s);
                    float* tp = isM ? tabM : tabS; tp[2 * y] = c; tp[2 * y + 1] = s;
                }
            }
            cv_lo = 0; cv_hi = 1; cv_w = gw; cv_n = NGW;
        } else if (ph == 1 && EN(101)) {
            GET_TID();
            for (int row = gw; row < MT; row += NGW) {
                const bool lat = row < ML;
                const float* xr = lat ? args.in[IN_X] + (size_t)row * DM : args.in[IN_CTX] + (size_t)(row - ML) * DM;
                const float* mp = MODS + (size_t)(lat ? (row >> 11) : 16) * 6144;
#pragma unroll
                for (int j = 0; j < 4; ++j) { const int col = 4 * lane + 256 * j;
                    const f32x4 v = *(const f32x4*)(xr + col), sh = *(const f32x4*)(mp + col), sc = *(const f32x4*)(mp + 1024 + col);
                    const f32x4 hv = v * (sc + 1.0f) + sh;
                    u32x2 w; w.x = cvt_pk_bf16(hv[0], hv[1]); w.y = cvt_pk_bf16(hv[2], hv[3]);
                    *(u32x2*)(HO + (size_t)row * DM + col) = w; }
            }
        } else {
            const int li = l >> 1; const bool even = !(l & 1); const bool with_ctx = l < 3;
            const float* modl = MODS + (size_t)l * 17 * 6144;
            const int Mrows = with_ctx ? MT : ML;
            if (kind == 0 && EN(0)) {
                pg8::Gemm g{HO, WB + w_win(l), MT, even ? ZE : ZO, DM, DM}; pg8::StaticOrder S; S.init(MT, g.N, G, (int)blockIdx.x);
                EpiZ E{Z, even ? ZE : ZO, even ? 0 : 1, tabM, tabS, SSQ};
                pg8::gemm_phase<EpiZ>(lds, g, S, E);
            } else if (kind == 1 && EN(1)) {
                for (int which = 0; which < 2; ++which) {
                    pg8::Gemm g; EpiQK E;
                    if (which == 0) { g = pg8::Gemm{Z + 1536, WB + w_uq(l), MT, 768, 384, ZE}; E = EpiQK{Q2, 768, SSQ, 12, 1.0f / 384.0f, 1, tabM}; }
                    else { g = pg8::Gemm{Z + 1920, WB + w_ukv(l), MT, 1024, 256, ZE}; E = EpiQK{KV2, 1024, SSQ + 12, 8, 1.0f / 256.0f, 0, tabM}; }
                    pg8::StaticOrder S; S.init(MT, g.N, G, (int)blockIdx.x);
                    pg8::gemm_phase<EpiQK>(lds, g, S, E);
                }
            } else if (kind == 2 && EN(2)) {
                GET_TID();
                const int nunits = with_ctx ? 2304 : 2048;
                if (wid >= 4) __builtin_amdgcn_s_setprio(3);
                LAS float* rpbl = (LAS float*)(lds + ATT_RPB);
                const int vblk = (G % 8 == 0) ? (int)(blockIdx.x % 8) * (G / 8) + (int)(blockIdx.x / 8) : (int)blockIdx.x;
                for (int ui = vblk; ui < nunits; ui += G) {
                    AttnDesc A; bool dq96 = false;
                    A.sink = -1e30f; A.mode = 0; A.a0 = 0; A.a1 = 0; A.a2 = 0; A.kr = Z; A.ldkr = 0; A.nloc = 0; A.loc_row0 = 0;
                    if (even) {
                        if (ui < 1024 || (ui >= 2048 && ui < 2176)) {
                            dq96 = true; int b, hh, qrow;
                            if (ui < 1024) { b = ui >> 6; hh = (ui >> 3) & 7; qrow = b * 2048 + 256 * (ui & 7); A.nloc = 32; A.loc_row0 = b * 2048; }
                            else { const int j = ui - 2048; b = j >> 3; hh = j & 7; qrow = ML + b * 256; }
                            qrow += 32 * wid; A.ctx_row0 = ML + b * 256;
                            A.q = Q2 + (size_t)qrow * 768 + 96 * hh; A.ldq = 768;
                            A.o = HO + (size_t)qrow * DM + 512 + 64 * hh; A.ldo = DM;
                            A.k = KV2 + 128 * hh; A.ldk = 1024; A.kr = Z + 2176; A.ldkr = ZE; A.v = KV2 + 128 * hh + 64; A.ldv = 1024;
                        } else {
                            int b, hh, qrow;
                            if (ui < 2048) { const int j = ui - 1024; b = j >> 6; hh = (j >> 3) & 7; const int R4 = j & 7; qrow = b * 2048 + 256 * R4;
                                const int lo = min(max(4 * R4 - 4, 0), 24), hi = min(max(4 * R4 - 1, 0), 24) + 8;
                                A.nloc = hi - lo; A.loc_row0 = b * 2048 + 64 * lo; A.mode = 1; A.a0 = lo; A.a1 = 4 * R4 + (wid >> 1); A.a2 = min(max(A.a1 - 4, 0), 24);
                                for (int x = tid; x < 465; x += 512) rpbl[x] = args.in[IN_RPB][(size_t)(li * 8 + hh) * 465 + x] * LOG2E;
                            } else { const int j = ui - 2176; b = j >> 3; hh = j & 7; qrow = ML + b * 256; }
                            qrow += 32 * wid; A.ctx_row0 = ML + b * 256;
                            A.q = Z + (size_t)qrow * ZE + 64 * hh; A.ldq = ZE; A.o = HO + (size_t)qrow * DM + 64 * hh; A.ldo = DM;
                            A.k = Z + 512 + 64 * hh; A.ldk = ZE; A.v = Z + 1024 + 64 * hh; A.ldv = ZE;
                        }
                    } else {
                        int b, qh, kvh, qrow;
                        if (ui < 2048) { b = ui >> 7; kvh = (ui >> 6) & 1; const int tb = ui & 63; const int q0 = 32 * tb; qh = 8 * kvh + wid; qrow = b * 2048 + q0;
                            const int ks64 = ((q0 - 128) >> 6) << 6;
                            const int tlo = ks64 < 0 ? (-ks64) >> 6 : 0; int thi = (2048 - ks64) >> 6; if (thi > 5) thi = 5;
                            A.nloc = thi - tlo; const int pos0 = ks64 + 64 * tlo; A.loc_row0 = b * 2048 + pos0; A.mode = 2; A.a0 = pos0; A.a1 = q0;
                        } else { const int j = ui - 2048; b = j >> 4; qh = j & 15; kvh = qh >> 3; qrow = ML + b * 256 + 32 * wid; }
                        A.ctx_row0 = ML + b * 256;
                        A.sink = args.in[IN_SINKS][li * 16 + qh] * LOG2E;
                        A.q = Z + (size_t)qrow * ZO + 64 * qh; A.ldq = ZO; A.o = HO + (size_t)qrow * DM + 64 * qh; A.ldo = DM;
                        A.k = Z + 1024 + 64 * kvh; A.ldk = ZO; A.v = Z + 1152 + 64 * kvh; A.ldv = ZO;
                    }
                    if (dq96) attn_unit_mla(lds, A, tid, wid, lane); else attn_unit<64>(lds, A, tid, wid, lane);
                }
                __builtin_amdgcn_s_setprio(0);
            } else if ((kind == 3 || kind == 7 || ((kind == 4 || kind == 8) && with_ctx && (blockIdx.x & 3) == 0)) && EN(3)) {
                const bool ctxpart = (kind == 4 || kind == 8);
                const bool isout = (kind == 3 || kind == 4);
                pg8::Gemm g; EpiRes E;
                const float* sL = (l == 0 && isout) ? args.in[IN_X] : XL; const float* sC = (l == 0 && isout) ? args.in[IN_CTX] : XC;
                if (isout) { g = pg8::Gemm{HO, WB + w_wout(l), MT, DM, DM, DM}; E = EpiRes{sL, sC, XL, XC, modl + 2048, nullptr, (l == 0) ? nullptr : STAT}; }
                else { g = pg8::Gemm{GB, WB + w_down(l), MT, DM, FFH, FFH}; E = EpiRes{sL, sC, XL, XC, modl + 5120, args.in[IN_BDOWN] + l * 1024, STAT}; }
                pg8::StaticOrder S;
                if (ctxpart) S.init(MC, DM, G / 4, (int)(blockIdx.x >> 2), ML / 256); else S.init(ML, DM, G, (int)blockIdx.x);
                pg8::gemm_phase<EpiRes>(lds, g, S, E);
            } else if ((kind == 4 || kind == 8 || kind == 9 || kind == 10) && EN(4)) {
                GET_TID();
                const bool first = (kind == 4 || kind == 9);
                const bool lastln = (l == 3 && kind == 8);
                const float* mp0 = first ? modl + 3072 : (lastln ? modl : modl + 17 * 6144);
                int rbeg = 0, rend = ML, wstart = gw, wstride = NGW;
                if (kind == 9 || kind == 10) { rbeg = ML; rend = MT; }
                else if (with_ctx) { const int bi = (int)blockIdx.x - (int)(blockIdx.x >> 2) - 1; wstart = bi * 8 + wid; wstride = (G - G / 4) * 8; }
                auto ln_row = [&](const int row, f32x4 (&v)[4]) __attribute__((always_inline)) {
                    const bool lat = row < ML;
                    float* xr = lat ? XL + (size_t)row * DM : XC + (size_t)(row - ML) * DM;
                    const float* mp = mp0 + (size_t)(lat ? (row >> 11) : 16) * 6144;
                    float s = 0.f;
#pragma unroll
                    for (int j = 0; j < 4; ++j) s += (v[j][0] + v[j][1]) + (v[j][2] + v[j][3]);
                    const float mean = wave_sum(s) * (1.0f / DM); float s2 = 0.f;
#pragma unroll
                    for (int j = 0; j < 4; ++j) { v[j] = v[j] - mean; s2 += (v[j][0] * v[j][0] + v[j][1] * v[j][1]) + (v[j][2] * v[j][2] + v[j][3] * v[j][3]); }
                    const float rstd = 1.0f / sqrtf(wave_sum(s2) * (1.0f / DM) + LN_EPS);
                    if (lane == 0) { STAT[2 * (size_t)row] = mean; STAT[2 * (size_t)row + 1] = rstd; }
#pragma unroll
                    for (int j = 0; j < 4; ++j) { const int col = 4 * lane + 256 * j; const f32x4 y = v[j] * rstd;
                        if (lastln) *(f32x4*)(xr + col) = y;
                        if (!lastln) { const f32x4 sh = *(const f32x4*)(mp + col), sc = *(const f32x4*)(mp + 1024 + col); const f32x4 hv = y * (sc + 1.0f) + sh;
                            u32x2 w; w.x = cvt_pk_bf16(hv[0], hv[1]); w.y = cvt_pk_bf16(hv[2], hv[3]); *(u32x2*)(HO + (size_t)row * DM + col) = w; } }
                };
                for (int row0 = rbeg + wstart; row0 < rend; row0 += 2 * wstride) {
                    const int row1 = row0 + wstride; const bool has1 = row1 < rend;
                    f32x4 va[4], vb[4];
#pragma unroll
                    for (int j = 0; j < 4; ++j) vb[j] = (f32x4){0.f, 0.f, 0.f, 0.f};
                    { const float* xp = (row0 < ML) ? XL + (size_t)row0 * DM : XC + (size_t)(row0 - ML) * DM;
#pragma unroll
                      for (int j = 0; j < 4; ++j) va[j] = *(const f32x4*)(xp + 4 * lane + 256 * j); }
                    if (has1) { const float* xp = (row1 < ML) ? XL + (size_t)row1 * DM : XC + (size_t)(row1 - ML) * DM;
#pragma unroll
                      for (int j = 0; j < 4; ++j) vb[j] = *(const f32x4*)(xp + 4 * lane + 256 * j); }
                    ln_row(row0, va);
                    if (has1) ln_row(row1, vb);
                }
                if (kind == 8 && with_ctx) { cv_lo = l + 1; cv_hi = l + 2; cv_w = wstart; cv_n = wstride; }
            } else if (kind == 5 && EN(5)) {
                pg8::Gemm g{HO, WB + w_up(l), Mrows, FF2, DM, DM}; pg8::StaticOrder S; S.init(Mrows, FF2, G, (int)blockIdx.x);
                EpiUp E{GB, HALO, args.in[IN_BUP] + (size_t)l * FF2, args.in[IN_CONVW] + (size_t)l * 3 * FF2, args.in[IN_CONVB] + (size_t)l * FF2, (LAS float*)(lds + 131072)};
                pg8::gemm_phase<EpiUp>(lds, g, S, E);
            } else if (kind == 6 && EN(6)) {
                GET_TID();
                const int nitems = (Mrows / 64) * 2;
                const float* bup = args.in[IN_BUP]; (void)bup;
                const float* cw = args.in[IN_CONVW] + (size_t)l * 3 * FF2; const float* cb = args.in[IN_CONVB] + (size_t)l * FF2;
                for (int it = gw; it < nitems * 11; it += NGW) {
                    const int ri = it / 11, chunk = it - ri * 11;
                    const int g64 = ri >> 1, which = ri & 1; const int row = 64 * g64 + (which ? 63 : 0);
                    const int tpos = row < ML ? (row & 2047) : ((row - ML) & 255); const int tlen = row < ML ? 2048 : 256;
                    const float* hc = HALO + (size_t)(g64 * 4 + (which ? 3 : 0)) * FF2;
                    const float* hp = which ? HALO + (size_t)(g64 * 4 + 2) * FF2 : (tpos > 0 ? HALO + (size_t)((g64 - 1) * 4 + 3) * FF2 : nullptr);
                    const float* hn = which ? (tpos < tlen - 1 ? HALO + (size_t)((g64 + 1) * 4 + 0) * FF2 : nullptr) : HALO + (size_t)(g64 * 4 + 1) * FF2;
                    const int c = 256 * chunk + 4 * lane;
                    const int na = ((c >> 7) << 8) + (c & 127), ng = na + 128;
                    const f32x4 z4 = (f32x4){0.f, 0.f, 0.f, 0.f};
                    const f32x4 ac = *(const f32x4*)(hc + na), gc = *(const f32x4*)(hc + ng);
                    const f32x4 ap = hp ? *(const f32x4*)(hp + na) : z4, gp = hp ? *(const f32x4*)(hp + ng) : z4;
                    const f32x4 an = hn ? *(const f32x4*)(hn + na) : z4, gn = hn ? *(const f32x4*)(hn + ng) : z4;
                    const f32x4 av = *(const f32x4*)(cw + c) * ap + *(const f32x4*)(cw + FF2 + c) * ac + *(const f32x4*)(cw + 2 * FF2 + c) * an + *(const f32x4*)(cb + c);
                    const f32x4 gv = *(const f32x4*)(cw + FFH + c) * gp + *(const f32x4*)(cw + FF2 + FFH + c) * gc + *(const f32x4*)(cw + 2 * FF2 + FFH + c) * gn + *(const f32x4*)(cb + FFH + c);
                    f32x4 o;
#pragma unroll
                    for (int e = 0; e < 4; ++e) o[e] = av[e] * gv[e] / (1.0f + __expf(-gv[e]));
                    u32x2 w; w.x = cvt_pk_bf16(o[0], o[1]); w.y = cvt_pk_bf16(o[2], o[3]);
                    *(u32x2*)(GB + (size_t)row * FFH + c) = w;
                }
            }
        }
        if (cv_hi > cv_lo) {
            int tid2 = threadIdx.x; asm volatile("" : "+v"(tid2));
            const int lane2 = tid2 & 63, wid2 = __builtin_amdgcn_readfirstlane(tid2 >> 6);
            LAS float* scr = (LAS float*)(lds + wid2 * 16640);
            int base = 0;
            for (int l2 = cv_lo; l2 < cv_hi; ++l2) {
                const int i = l2 >> 1; const bool even2 = !(l2 & 1);
                for (int kd = 0; kd < 6; ++kd) {
                    const float* W; int K, N, Np, mapmode = 0; const float* ks = nullptr; size_t dst;
                    if (kd == 0) { if (even2) { W = args.in[IN_WINE] + (size_t)i * 1024 * 2208; K = 1024; N = 2208; Np = ZE; } else { W = args.in[IN_WINO] + (size_t)i * 1024 * 1280; K = 1024; N = 1280; Np = ZO; } dst = w_win(l2); }
                    else if (kd == 1) { if (!even2) continue; W = args.in[IN_WUQ] + (size_t)i * 384 * 768; K = 384; N = 768; Np = 768; ks = args.in[IN_QNORM] + i * 384; dst = w_uq(l2); }
                    else if (kd == 2) { if (!even2) continue; W = args.in[IN_WUKV] + (size_t)i * 256 * 1024; K = 256; N = 1024; Np = 1024; ks = args.in[IN_KVNORM] + i * 256; dst = w_ukv(l2); }
                    else if (kd == 3) { W = (even2 ? args.in[IN_WOUTE] : args.in[IN_WOUTO]) + (size_t)i * 1024 * 1024; K = 1024; N = 1024; Np = 1024; dst = w_wout(l2); }
                    else if (kd == 4) { W = args.in[IN_WUP] + (size_t)l2 * 1024 * FF2; K = 1024; N = FF2; Np = FF2; mapmode = 1; dst = w_up(l2); }
                    else { W = args.in[IN_WDOWN] + (size_t)l2 * FFH * 1024; K = FFH; N = 1024; Np = 1024; dst = w_down(l2); }
                    const int nitems = (K / 64) * (Np / 64);
                    int first = (cv_w - base) % cv_n; if (first < 0) first += cv_n;
                    for (int it = first; it < nitems; it += cv_n) conv_item(W, K, N, Np, WB + dst, ks, mapmode, scr, it, lane2);
                    base += nitems;
                }
            }
        }
        for (int xs = 0; xs < PROBE_XSYNC; ++xs) xcd_barrier(xbar);
        if (ph + 1 < args.ph_hi) { if (ph == 0) grid.sync(); else xcd_barrier(xbar); }
    }
}

extern "C" void kernel_launch(void* const* d_in, const int* in_sizes, int n_in, void* d_out, int out_size, void* d_ws, size_t ws_size, hipStream_t stream) {
    static int grid = 0;
    if (grid == 0) {
        if (n_in != 22 || ws_size < WS_END) { fprintf(stderr, "kernel_launch: unexpected inputs (n_in %d, ws %zu)\n", n_in, ws_size); grid = -1; return; }
        int dev = 0, cus = 0, per_cu = 0;
        hipGetDevice(&dev); hipDeviceGetAttribute(&cus, hipDeviceAttributeMultiprocessorCount, dev);
        hipFuncSetAttribute((const void*)mk_fwd, hipFuncAttributeMaxDynamicSharedMemorySize, LDS_BYTES);
        hipOccupancyMaxActiveBlocksPerMultiprocessor(&per_cu, (const void*)mk_fwd, 512, LDS_BYTES);
        if (per_cu < 1) { fprintf(stderr, "kernel_launch: occupancy query says %d blocks/CU\n", per_cu); per_cu = 1; }
        (void)hipGetLastError();
        grid = cus;
    }
    if (grid < 0) return;
    if (hipMemsetAsync(d_ws, 0, 16384, stream) != hipSuccess) { fprintf(stderr, "kernel_launch: memset failed\n"); return; }
    Args a{};
    for (int i = 0; i < 22; ++i) a.in[i] = (const float*)d_in[i];
    a.out = (float*)d_out; a.ws = (unsigned char*)d_ws;
#if MK_PER_PHASE_LAUNCH
    for (int ph = 0; ph < N_PHASES; ++ph) { a.ph_lo = ph; a.ph_hi = ph + 1; hipLaunchKernelGGL(mk_fwd, dim3(grid), dim3(512), LDS_BYTES, stream, a); }
#else
    a.ph_lo = 0; a.ph_hi = N_PHASES;
    void* kargs[] = {&a};
    hipError_t e = hipLaunchCooperativeKernel((const void*)mk_fwd, dim3(grid), dim3(512), kargs, LDS_BYTES, stream);
    if (e != hipSuccess) fprintf(stderr, "cooperative launch failed: %s (grid %d)\n", hipGetErrorString(e), grid);
#endif
}
```

```cpp
#include <hip/hip_runtime.h>
#include <hip/hip_cooperative_groups.h>
#include <cstdint>
#include <cstdio>
namespace cg = cooperative_groups;

#ifndef MK_PER_PHASE_LAUNCH
#define MK_PER_PHASE_LAUNCH 0
#endif

#define LAS __attribute__((address_space(3)))
#define GET_TID() int tid_ = threadIdx.x; asm volatile("" : "+v"(tid_)); const int tid = tid_, lane = tid & 63, wid = __builtin_amdgcn_readfirstlane(tid >> 6); const int gw = blockIdx.x * 8 + wid; (void)gw; (void)lane; (void)tid
#ifdef ONLY
#define EN(x) ((x) == ONLY)
#else
#define EN(x) true
#endif
typedef unsigned short bf16_t;
typedef short bf16x8 __attribute__((ext_vector_type(8)));
typedef short s16x4 __attribute__((ext_vector_type(4)));
typedef float f32x4 __attribute__((ext_vector_type(4)));
typedef float f32x16 __attribute__((ext_vector_type(16)));
typedef unsigned u32x4 __attribute__((ext_vector_type(4)));
typedef unsigned u32x2 __attribute__((ext_vector_type(2)));

constexpr int DM = 1024, NBATCH = 16, SEQL = 2048, CTXL = 256;
constexpr int ML = NBATCH * SEQL;
constexpr int MC = NBATCH * CTXL;
constexpr int MT = ML + MC;
constexpr int ZE = 2304, ZO = 1280, FFH = 2816, FF2 = 5632;
constexpr float LOG2E = 1.4426950408889634f;
constexpr float QS64 = 0.125f * LOG2E;
constexpr float QS96 = 0.10206207261596575f * LOG2E;
constexpr float ALPHA = 1.681792830507429f;
constexpr float LN_EPS = 1e-6f, RMS_EPS = 1e-6f;

constexpr size_t MiB = 1u << 20;
constexpr size_t WS_MODS = 1 * MiB;
constexpr size_t WS_TAB = 3 * MiB;
constexpr size_t WS_XC = 4 * MiB;
constexpr size_t WS_W = 20 * MiB;
constexpr size_t WS_HO = 112 * MiB;
constexpr size_t WS_Z = 184 * MiB;
constexpr size_t WS_Q2 = 346 * MiB;
constexpr size_t WS_KV2 = 400 * MiB;
constexpr size_t WS_G = WS_Z;
constexpr size_t WS_HALO = WS_KV2;
constexpr size_t WS_STAT = 472 * MiB;
constexpr size_t WS_SSQ = 473 * MiB;
constexpr size_t WS_END = 476 * MiB;

constexpr size_t W_EVEN = 2359296 + 294912 + 262144 + 1048576;
constexpr size_t W_ODD = 1310720 + 1048576;
constexpr size_t W_FFN = 5767168 + 2883584;
__host__ __device__ constexpr size_t w_layer_off(int l) { return (size_t)(l / 2) * (W_EVEN + W_ODD) + (size_t)l * W_FFN + ((l & 1) ? W_EVEN : 0); }
__host__ __device__ constexpr size_t w_win(int l) { return w_layer_off(l); }
__host__ __device__ constexpr size_t w_uq(int l) { return w_layer_off(l) + 2359296; }
__host__ __device__ constexpr size_t w_ukv(int l) { return w_layer_off(l) + 2359296 + 294912; }
__host__ __device__ constexpr size_t w_wout(int l) { return w_layer_off(l) + ((l & 1) ? 1310720 : (2359296 + 294912 + 262144)); }
__host__ __device__ constexpr size_t w_up(int l) { return w_wout(l) + 1048576; }
__host__ __device__ constexpr size_t w_down(int l) { return w_up(l) + 5767168; }
static_assert(w_down(3) + 2883584 == 47251456, "weight map");
static_assert(WS_W + 47251456ull * 2 <= WS_HO, "weight region");

constexpr int LDS_BYTES = 147456;
constexpr int PROBE_KIND = -1;
constexpr int PROBE_XSYNC = 0;

__device__ __forceinline__ unsigned cvt_pk_bf16(float lo, float hi) { unsigned r; asm("v_cvt_pk_bf16_f32 %0, %1, %2" : "=v"(r) : "v"(lo), "v"(hi)); return r; }
typedef float f32x2_cv __attribute__((ext_vector_type(2))); typedef __bf16 bf16x2_cv __attribute__((ext_vector_type(2)));
__device__ __forceinline__ unsigned cvt_pk_bf16_m(float lo, float hi) { const f32x2_cv v = {lo, hi}; const bf16x2_cv b = __builtin_convertvector(v, bf16x2_cv); return __builtin_bit_cast(unsigned, b); }
__device__ __forceinline__ float bf_lo(unsigned w) { return __uint_as_float(w << 16); }
__device__ __forceinline__ float bf_hi(unsigned w) { return __uint_as_float(w & 0xffff0000u); }

namespace pg8 {
constexpr int BM = 256, BK = 64, HALF = 128, HTB = HALF * BK * 2, STAGE_BYTES = 8 * HTB, NXCD = 8, WGM = 8;
__host__ __device__ __forceinline__ int lds_byte(int r, int c) { const int st = (r >> 4) * 2 + (c >> 5), rr = r & 15, cc = c & 31, ob = rr * 64 + cc * 2; return st * 1024 + (ob ^ (((ob >> 9) & 1) << 5)); }
__host__ __device__ __forceinline__ void stage_rc(int b, int& R, int& C) { const int st = b / 1024, sb = b % 1024, swz = sb ^ (((sb >> 9) & 1) << 5); R = (st >> 1) * 16 + swz / 64; C = (st & 1) * 32 + (swz % 64) / 2; }
__host__ __device__ __forceinline__ int perm32(int rho) { const int n = rho >> 4, i = rho & 15; return 8 * (i >> 2) + 4 * n + (i & 3); }
struct Unit { int pm, pn; };
struct Gemm { const bf16_t* A; const bf16_t* Bt; int M, N, K, lda; };
struct StaticOrder {
    int nM, nN, nwg, G, c, pm_off;
    __device__ void init(int M, int N, int G_, int c_, int pm_off_ = 0) { nM = M / BM; nN = N / BM; nwg = nM * nN; G = G_; c = c_; pm_off = pm_off_; }
    __device__ bool next(int i, Unit& u) const {
        const long L = (long)i * G + c; if (L >= nwg) return false;
        int wgid = (int)L; { const int q = nwg / NXCD, r = nwg % NXCD, xcd = wgid % NXCD, off = wgid / NXCD; wgid = (xcd < r ? xcd * (q + 1) : r * (q + 1) + (xcd - r) * q) + off; }
        const int nig = WGM * nN, gid = wgid / nig, fm = gid * WGM, gsz = (nM - fm) < WGM ? (nM - fm) : WGM;
        u.pm = pm_off + fm + ((wgid % nig) % gsz); u.pn = (wgid % nig) / gsz; return true;
    }
};
template <class Epi>
__device__ __forceinline__ void gemm_phase(LAS unsigned char* lds, const Gemm g, const StaticOrder& S, const Epi& E) {
    int tid_ = threadIdx.x; asm volatile("" : "+v"(tid_));
    const int tid = tid_, wid = __builtin_amdgcn_readfirstlane(tid >> 6), lane = tid & 63, wr = wid >> 2, wc = wid & 3, fr = lane & 15, fq = lane >> 4;
    const int K = g.K, nt = K / BK, lda = g.lda;
    unsigned voffA[2], voffB[2];
#pragma unroll
    for (int i = 0; i < 2; ++i) { int R, C; stage_rc(tid * 16 + i * 8192, R, C); const int Rb = (R & ~31) + perm32(R & 31);
        const int Ra = (R & ~63) + 4 * (R & 15) + ((R >> 4) & 3);
        voffA[i] = (unsigned)(Ra * lda + C) * 2u; voffB[i] = (unsigned)(Rb * K + C) * 2u; }
    const size_t kstep = (size_t)(BK * 2);
    const size_t hstepA = (size_t)HALF * lda * 2, hstepB = (size_t)HALF * K * 2;
    const size_t tstepA = 2 * hstepA, tstepB = 2 * hstepB;
    const unsigned ldsw = (unsigned)wid * 1024u;
    const int aoff = lds_byte(wr * 64 + fr, fq * 8), boff = lds_byte(wc * 32 + fr, fq * 8);
#define PG8_SA(b, h) (((b) * 2 + (h)) * HTB)
#define PG8_SB(b, h) ((4 + (b) * 2 + (h)) * HTB)
#define PG8_STAGE(bufoff, gbase, voff) do { _Pragma("unroll") for (int _i = 0; _i < 2; ++_i) \
        __builtin_amdgcn_global_load_lds((const unsigned*)((const char*)(gbase) + (voff)[_i]), (LAS unsigned*)(lds + (bufoff) + ldsw + _i * 8192), 16, 0, 0); } while (0)
#define PG8_LDA(dst, b, h) do { _Pragma("unroll") for (int m = 0; m < 4; ++m) _Pragma("unroll") for (int k = 0; k < 2; ++k) dst[m][k] = *(const LAS bf16x8*)(lds + PG8_SA(b, h) + aoff + m * 2048 + k * 1024); } while (0)
#define PG8_LDB(dst, b, h) do { _Pragma("unroll") for (int n = 0; n < 2; ++n) _Pragma("unroll") for (int k = 0; k < 2; ++k) dst[n][k] = *(const LAS bf16x8*)(lds + PG8_SB(b, h) + boff + n * 2048 + k * 1024); } while (0)
#define PG8_MMA(ai, bj, At, Bt) do { __builtin_amdgcn_s_setprio(1); _Pragma("unroll") for (int m = 0; m < 4; ++m) _Pragma("unroll") for (int n = 0; n < 2; ++n) _Pragma("unroll") for (int k = 0; k < 2; ++k) \
        acc[ai][bj][m][n] = __builtin_amdgcn_mfma_f32_16x16x32_bf16(Bt[n][k], At[m][k], acc[ai][bj][m][n], 0, 0, 0); __builtin_amdgcn_s_setprio(0); } while (0)
#define PG8_WAIT_V(n) asm volatile("s_waitcnt vmcnt(" #n ")" ::: "memory")
#define PG8_WAIT_L(n) asm volatile("s_waitcnt lgkmcnt(" #n ")" ::: "memory")
#define PG8_BAR __builtin_amdgcn_s_barrier()
#define PG8_SCHED __builtin_amdgcn_sched_barrier(0)
    Unit cur, nxt; int ui = 0;
    if (!S.next(0, cur)) return;
    f32x4 acc[2][2][4][2];
#pragma unroll
    for (int a = 0; a < 2; ++a)
#pragma unroll
        for (int b = 0; b < 2; ++b)
#pragma unroll
            for (int m = 0; m < 4; ++m)
#pragma unroll
                for (int n = 0; n < 2; ++n) acc[a][b][m][n] = (f32x4){0.f, 0.f, 0.f, 0.f};
    bf16x8 At[4][2], B0[2][2], B1[2][2];
    const char* cA = (const char*)g.A + (size_t)cur.pm * tstepA; const char* cB = (const char*)g.Bt + (size_t)cur.pn * tstepB;
    PG8_STAGE(PG8_SB(0, 0), cB, voffB); PG8_STAGE(PG8_SB(0, 1), cB + hstepB, voffB); PG8_STAGE(PG8_SA(0, 0), cA, voffA); PG8_STAGE(PG8_SA(0, 1), cA + hstepA, voffA);
    if (wr == 1) PG8_BAR;
    PG8_WAIT_V(2); PG8_BAR;
    PG8_STAGE(PG8_SB(1, 0), cB + kstep, voffB); PG8_STAGE(PG8_SA(1, 0), cA + kstep, voffA); PG8_STAGE(PG8_SB(1, 1), cB + hstepB + kstep, voffB);
    PG8_WAIT_V(6); PG8_BAR;
    for (;;) {
        const bool has_next = S.next(ui + 1, nxt);
        const char* nA = has_next ? (const char*)g.A + (size_t)nxt.pm * tstepA : cA; const char* nB = has_next ? (const char*)g.Bt + (size_t)nxt.pn * tstepB : cB;
        for (int t = 0; t < nt; t += 2) {
            const bool last = (t == nt - 2);
            if constexpr (Epi::PREFETCH) { if (t == 2) E.prefetch(cur, wr, wc, lane); }
            const char* a1 = cA + (size_t)(t + 1) * kstep;
            const char* a2 = last ? nA : cA + (size_t)(t + 2) * kstep; const char* b2 = last ? nB : cB + (size_t)(t + 2) * kstep;
            const char* a3 = a2 + kstep; const char* b3 = b2 + kstep;
            PG8_LDB(B0, 0, 0); PG8_LDB(B1, 0, 1); PG8_SCHED; PG8_LDA(At, 0, 0); PG8_STAGE(PG8_SA(1, 1), a1 + hstepA, voffA);
            PG8_WAIT_V(8); PG8_WAIT_L(0); PG8_BAR; PG8_MMA(0, 0, At, B0); PG8_MMA(0, 1, At, B1); PG8_BAR; PG8_SCHED;
            PG8_LDA(At, 0, 1); PG8_STAGE(PG8_SB(0, 0), b2, voffB); PG8_STAGE(PG8_SB(0, 1), b2 + hstepB, voffB); PG8_STAGE(PG8_SA(0, 0), a2, voffA);
            PG8_WAIT_V(8); PG8_WAIT_L(0); PG8_BAR; PG8_MMA(1, 0, At, B0); PG8_MMA(1, 1, At, B1); PG8_BAR; PG8_SCHED;
            PG8_LDB(B0, 1, 0); PG8_LDB(B1, 1, 1); PG8_SCHED; PG8_LDA(At, 1, 0); PG8_STAGE(PG8_SA(0, 1), a2 + hstepA, voffA);
            PG8_WAIT_V(8); PG8_WAIT_L(0); PG8_BAR; PG8_MMA(0, 0, At, B0); PG8_MMA(0, 1, At, B1); PG8_BAR; PG8_SCHED;
            PG8_LDA(At, 1, 1); PG8_STAGE(PG8_SB(1, 0), b3, voffB); PG8_STAGE(PG8_SB(1, 1), b3 + hstepB, voffB); PG8_STAGE(PG8_SA(1, 0), a3, voffA);
            PG8_WAIT_V(8); PG8_WAIT_L(0); PG8_BAR; PG8_MMA(1, 0, At, B0); PG8_MMA(1, 1, At, B1); PG8_BAR; PG8_SCHED;
        }
        if (wr == 0) PG8_BAR;
        E(acc, cur, wr, wc, fr, fq);
        if (!has_next) break;
#pragma unroll
        for (int a = 0; a < 2; ++a)
#pragma unroll
            for (int b = 0; b < 2; ++b)
#pragma unroll
                for (int m = 0; m < 4; ++m)
#pragma unroll
                    for (int n = 0; n < 2; ++n) acc[a][b][m][n] = (f32x4){0.f, 0.f, 0.f, 0.f};
        cur = nxt; cA = nA; cB = nB; ++ui;
        if (wr == 1) PG8_BAR;
    }
    PG8_WAIT_V(0);
    PG8_BAR;
#undef PG8_SA
#undef PG8_SB
#undef PG8_STAGE
#undef PG8_LDA
#undef PG8_LDB
#undef PG8_MMA
#undef PG8_WAIT_V
#undef PG8_WAIT_L
#undef PG8_BAR
#undef PG8_SCHED
}
}
using pg8::Unit;

__device__ __forceinline__ void rope_apply(f32x4& v0, f32x4& v1, int kind, int row, int wc, int fq, const float* tabM, const float* tabS) {
    const int t = row & 2047, gr = t >> 6, gc = t & 63;
    const float* tb; float sgn; f32x4 p0, p1;
    if (kind == 1) {
        const int pos = (fq < 2) ? gr : gc; tb = tabM + pos * 16; sgn = (fq & 1) ? 1.f : -1.f;
#pragma unroll
        for (int e = 0; e < 4; ++e) { p0[e] = __shfl_xor(v0[e], 16); p1[e] = __shfl_xor(v1[e], 16); }
    } else {
        const int pos = (wc & 1) ? gc : gr; tb = tabS + pos * 32 + (fq & 1) * 16; sgn = (fq & 2) ? 1.f : -1.f;
#pragma unroll
        for (int e = 0; e < 4; ++e) { p0[e] = __shfl_xor(v0[e], 32); p1[e] = __shfl_xor(v1[e], 32); }
    }
    const f32x4 c0 = *(const f32x4*)(tb), c1 = *(const f32x4*)(tb + 4), c2 = *(const f32x4*)(tb + 8), c3 = *(const f32x4*)(tb + 12);
    v0[0] = v0[0] * c0[0] + sgn * p0[0] * c0[1]; v0[1] = v0[1] * c0[2] + sgn * p0[1] * c0[3];
    v0[2] = v0[2] * c1[0] + sgn * p0[2] * c1[1]; v0[3] = v0[3] * c1[2] + sgn * p0[3] * c1[3];
    v1[0] = v1[0] * c2[0] + sgn * p1[0] * c2[1]; v1[1] = v1[1] * c2[2] + sgn * p1[1] * c2[3];
    v1[2] = v1[2] * c3[0] + sgn * p1[2] * c3[1]; v1[3] = v1[3] * c3[2] + sgn * p1[3] * c3[3];
}
__device__ __forceinline__ void store_bf16x8(bf16_t* p, f32x4 v0, f32x4 v1) {
    u32x4 w; w.x = cvt_pk_bf16(v0[0], v0[1]); w.y = cvt_pk_bf16(v0[2], v0[3]); w.z = cvt_pk_bf16(v1[0], v1[1]); w.w = cvt_pk_bf16(v1[2], v1[3]);
    *(u32x4*)p = w;
}

struct EpiZ { static constexpr bool PREFETCH = false;
    bf16_t* Z; int ldz; int odd; const float* tabM; const float* tabS; float* ssq;
    __device__ __forceinline__ void operator()(const f32x4 (&acc)[2][2][4][2], const Unit& u, int wr_in, int wc_in, int fr_in, int fq_in) const {
        int fr = fr_in, fq = fq_in, wr = wr_in, wc = wc_in; asm volatile("" : "+v"(fr), "+v"(fq), "+s"(wr), "+s"(wc));
        const bool lat = u.pm < 128;
#pragma unroll
        for (int bj = 0; bj < 2; ++bj) {
            const int g32 = u.pn * 8 + bj * 4 + wc;
            if (!odd && g32 >= 48 && g32 < 68) {
#pragma unroll
                for (int ai = 0; ai < 2; ++ai)
#pragma unroll
                    for (int m = 0; m < 4; ++m) {
                        const f32x4 a = acc[ai][bj][m][0], b = acc[ai][bj][m][1];
                        float ss = (a[0] * a[0] + a[1] * a[1]) + (a[2] * a[2] + a[3] * a[3]) + (b[0] * b[0] + b[1] * b[1]) + (b[2] * b[2] + b[3] * b[3]);
                        ss += __shfl_xor(ss, 16); ss += __shfl_xor(ss, 32);
                        if (fq == 0) ssq[(size_t)(u.pm * 256 + ai * 128 + wr * 64 + 4 * fr + m) * 20 + (g32 - 48)] = ss;
                    }
            }
            int rope = 0; float sc = 1.f;
            if (!odd) { if (g32 < 16) sc = QS64; if (g32 == 68 && lat) rope = 1; }
            else { if (g32 < 32) sc = QS64; if (g32 < 36 && lat) rope = 2; }
            const int col0 = g32 * 32 + 8 * fq;
#pragma unroll
            for (int ai = 0; ai < 2; ++ai)
#pragma unroll
                for (int m = 0; m < 4; ++m) {
                    const int row = u.pm * 256 + ai * 128 + wr * 64 + 4 * fr + m;
                    f32x4 v0 = acc[ai][bj][m][0], v1 = acc[ai][bj][m][1];
                    if (rope) rope_apply(v0, v1, rope, row, wc, fq, tabM, tabS);
                    v0 = v0 * sc; v1 = v1 * sc;
                    store_bf16x8(Z + (size_t)row * ldz + col0, v0, v1);
                }
        }
    }
};
struct EpiQK { static constexpr bool PREFETCH = false;
    bf16_t* O; int ldo; const float* ssq; int nslot; float invn; int isq; const float* tabM;
    __device__ __forceinline__ void operator()(const f32x4 (&acc)[2][2][4][2], const Unit& u, int wr_in, int wc_in, int fr_in, int fq_in) const {
        int fr = fr_in, fq = fq_in, wr = wr_in, wc = wc_in; asm volatile("" : "+v"(fr), "+v"(fq), "+s"(wr), "+s"(wc));
        const bool lat = u.pm < 128;
        const float sc = isq ? QS96 : 1.f;
#pragma unroll
        for (int ai = 0; ai < 2; ++ai)
#pragma unroll
            for (int m = 0; m < 4; ++m) {
                const int row = u.pm * 256 + ai * 128 + wr * 64 + 4 * fr + m;
                const float* sp = ssq + (size_t)row * 20;
                const f32x4 p0 = *(const f32x4*)(sp), p1 = *(const f32x4*)(sp + 4);
                float ss = (p0[0] + p0[1]) + (p0[2] + p0[3]) + (p1[0] + p1[1]) + (p1[2] + p1[3]);
                if (nslot == 12) { const f32x4 p2 = *(const f32x4*)(sp + 8); ss += (p2[0] + p2[1]) + (p2[2] + p2[3]); }
                const float rs = sc / sqrtf(ss * invn + RMS_EPS);
#pragma unroll
                for (int bj = 0; bj < 2; ++bj) {
                    const int g32 = u.pn * 8 + bj * 4 + wc;
                    const int rope = (isq && lat && (g32 % 3 == 2)) ? 1 : 0;
                    f32x4 v0 = acc[ai][bj][m][0] * rs, v1 = acc[ai][bj][m][1] * rs;
                    if (rope) rope_apply(v0, v1, 1, row, wc, fq, tabM, tabM);
                    store_bf16x8(O + (size_t)row * ldo + g32 * 32 + 8 * fq, v0, v1);
                }
            }
    }
};
struct EpiRes { static constexpr bool PREFETCH = false;
    const float* srcL; const float* srcC; float* dstL; float* dstC; const float* gate; const float* bias; const float* stat;
    __device__ __forceinline__ void operator()(const f32x4 (&acc)[2][2][4][2], const Unit& u, int wr_in, int wc_in, int fr_in, int fq_in) const {
        int fr = fr_in, fq = fq_in, wr = wr_in, wc = wc_in; asm volatile("" : "+v"(fr), "+v"(fq), "+s"(wr), "+s"(wc));
        const bool lat = u.pm < 128;
        const int b = lat ? (u.pm >> 3) : 16;
        const float* gp = gate + (size_t)b * 6144;
        const float* src = lat ? srcL : srcC; float* dst = lat ? dstL : dstC;
        const int rbase = (lat ? u.pm : (u.pm - 128)) * 256 + wr * 64 + 4 * fr;
        const int colw = u.pn * 256 + wc * 32 + 8 * fq;
#pragma unroll
        for (int ai = 0; ai < 2; ++ai) {
            float sa[4], sb[4];
#pragma unroll
            for (int m = 0; m < 4; ++m) { sa[m] = ALPHA; sb[m] = 0.f;
                if (stat) { const float2 st = *(const float2*)(stat + 2 * (size_t)(u.pm * 256 + wr * 64 + 4 * fr + ai * 128 + m)); sa[m] = ALPHA * st.y; sb[m] = -sa[m] * st.x; } }
#pragma unroll
            for (int bj = 0; bj < 2; ++bj) {
                const int col0 = colw + bj * 128;
                f32x4 x[4][2];
#pragma unroll
                for (int m = 0; m < 4; ++m) { const float* p = src + (size_t)(rbase + ai * 128 + m) * DM + col0; x[m][0] = *(const f32x4*)(p); x[m][1] = *(const f32x4*)(p + 4); }
                const f32x4 g0 = *(const f32x4*)(gp + col0), g1 = *(const f32x4*)(gp + col0 + 4);
                f32x4 b0 = (f32x4){0.f, 0.f, 0.f, 0.f}, b1 = b0;
                if (bias) { b0 = *(const f32x4*)(bias + col0); b1 = *(const f32x4*)(bias + col0 + 4); }
#pragma unroll
                for (int m = 0; m < 4; ++m) {
                    float* q = dst + (size_t)(rbase + ai * 128 + m) * DM + col0;
                    const f32x4 r0 = x[m][0] * sa[m] + sb[m] + g0 * (acc[ai][bj][m][0] + b0), r1 = x[m][1] * sa[m] + sb[m] + g1 * (acc[ai][bj][m][1] + b1);
                    *(f32x4*)(q) = r0; *(f32x4*)(q + 4) = r1;
                }
                __builtin_amdgcn_sched_barrier(0);
            }
        }
    }
};
__device__ __forceinline__ float dpp_shr1(float v) { return __builtin_bit_cast(float, __builtin_amdgcn_update_dpp(0, __builtin_bit_cast(int, v), 0x111, 0xf, 0xf, true)); }
__device__ __forceinline__ float dpp_shl1(float v) { return __builtin_bit_cast(float, __builtin_amdgcn_update_dpp(0, __builtin_bit_cast(int, v), 0x101, 0xf, 0xf, true)); }
struct EpiUp { static constexpr bool PREFETCH = true;
    bf16_t* G; float* halo; const float* b_up; const float* conv_w; const float* conv_b; LAS float* pl;
    __device__ __forceinline__ void prefetch(const Unit& u, int wr, int wc, int lane_in) const {
        int lane = lane_in; asm volatile("" : "+v"(lane));
        const int cw0 = u.pn * 128 + wc * 32;
        LAS float* P = pl + (wr * 4 + wc) * 320;
#pragma unroll
        for (int k = 0; k < 5; ++k) { const int idx = lane + 64 * k, p = idx >> 5, c = idx & 31; const int col = cw0 + c + (p >= 5 ? FFH : 0); const int pp = p >= 5 ? p - 5 : p;
            const float* src = (pp == 0) ? b_up + col : (pp == 4) ? conv_b + col : conv_w + (size_t)(pp - 1) * FF2 + col;
            __builtin_amdgcn_global_load_lds((const unsigned*)src, (LAS unsigned*)(P + 64 * k), 4, 0, 0); }
    }
    __device__ __forceinline__ void operator()(const f32x4 (&acc)[2][2][4][2], const Unit& u, int wr_in, int wc_in, int fr_in, int fq_in) const {
        typedef float f32x2 __attribute__((ext_vector_type(2)));
        int fr = fr_in, fq = fq_in, wr = wr_in, wc = wc_in; asm volatile("" : "+v"(fr), "+v"(fq), "+s"(wr), "+s"(wc));
        const int lane = fq * 16 + fr;
        const int cw0 = u.pn * 128 + wc * 32;
        const int ca0 = cw0 + 8 * fq;
        const int tcol0 = u.pn * 256 + wc * 32 + 8 * fq;
        LAS float* P = pl + (wr * 4 + wc) * 320;
        (void)lane;
#pragma unroll
        for (int ai = 0; ai < 2; ++ai) {
            if (fr == 0 || fr == 15) {
                const int g64 = u.pm * 4 + ai * 2 + wr;
                float* hp = halo + ((size_t)(g64 * 4 + (fr ? 2 : 0))) * FF2 + tcol0;
#pragma unroll
                for (int n = 0; n < 2; ++n) {
                    const f32x4 bua = *(const LAS f32x4*)(P + 8 * fq + 4 * n), bug = *(const LAS f32x4*)(P + 160 + 8 * fq + 4 * n);
                    const f32x4 a0 = fr ? acc[ai][0][2][n] : acc[ai][0][0][n], a1 = fr ? acc[ai][0][3][n] : acc[ai][0][1][n];
                    const f32x4 g0 = fr ? acc[ai][1][2][n] : acc[ai][1][0][n], g1 = fr ? acc[ai][1][3][n] : acc[ai][1][1][n];
                    *(f32x4*)(hp + 4 * n) = a0 + bua; *(f32x4*)(hp + 128 + 4 * n) = g0 + bug;
                    *(f32x4*)(hp + FF2 + 4 * n) = a1 + bua; *(f32x4*)(hp + FF2 + 128 + 4 * n) = g1 + bug;
                }
            }
            u32x4 pk[4];
#pragma unroll
            for (int n = 0; n < 2; ++n)
#pragma unroll
                for (int ep = 0; ep < 2; ++ep) {
                    const int e0 = 2 * ep; const LAS float* pc = P + 8 * fq + 4 * n + e0;
                    const f32x2 bua = *(const LAS f32x2*)(pc), w0a = *(const LAS f32x2*)(pc + 32), w1a = *(const LAS f32x2*)(pc + 64), w2a = *(const LAS f32x2*)(pc + 96), cba = *(const LAS f32x2*)(pc + 128);
                    const f32x2 bug = *(const LAS f32x2*)(pc + 160), w0g = *(const LAS f32x2*)(pc + 192), w1g = *(const LAS f32x2*)(pc + 224), w2g = *(const LAS f32x2*)(pc + 256), cbg = *(const LAS f32x2*)(pc + 288);
                    f32x2 av[4];
                    {
                        f32x2 x[4], pv, nv;
#pragma unroll
                        for (int m = 0; m < 4; ++m) { x[m].x = acc[ai][0][m][n][e0]; x[m].y = acc[ai][0][m][n][e0 + 1]; x[m] = x[m] + bua; }
                        pv.x = dpp_shr1(x[3].x); pv.y = dpp_shr1(x[3].y); nv.x = dpp_shl1(x[0].x); nv.y = dpp_shl1(x[0].y);
                        av[0] = w0a * pv + w1a * x[0] + w2a * x[1] + cba;
                        av[1] = w0a * x[0] + w1a * x[1] + w2a * x[2] + cba;
                        av[2] = w0a * x[1] + w1a * x[2] + w2a * x[3] + cba;
                        av[3] = w0a * x[2] + w1a * x[3] + w2a * nv + cba;
                    }
                    {
                        f32x2 x[4], pv, nv, gv[4];
#pragma unroll
                        for (int m = 0; m < 4; ++m) { x[m].x = acc[ai][1][m][n][e0]; x[m].y = acc[ai][1][m][n][e0 + 1]; x[m] = x[m] + bug; }
                        pv.x = dpp_shr1(x[3].x); pv.y = dpp_shr1(x[3].y); nv.x = dpp_shl1(x[0].x); nv.y = dpp_shl1(x[0].y);
                        gv[0] = w0g * pv + w1g * x[0] + w2g * x[1] + cbg;
                        gv[1] = w0g * x[0] + w1g * x[1] + w2g * x[2] + cbg;
                        gv[2] = w0g * x[1] + w1g * x[2] + w2g * x[3] + cbg;
                        gv[3] = w0g * x[2] + w1g * x[3] + w2g * nv + cbg;
#pragma unroll
                        for (int m = 0; m < 4; ++m) {
                            const f32x2 t = gv[m] * (-LOG2E);
                            f32x2 sg; sg.x = __builtin_amdgcn_rcpf(1.0f + __builtin_amdgcn_exp2f(t.x)); sg.y = __builtin_amdgcn_rcpf(1.0f + __builtin_amdgcn_exp2f(t.y));
                            const f32x2 ov = av[m] * gv[m] * sg;
                            pk[m][2 * n + ep] = cvt_pk_bf16(ov.x, ov.y); }
                    }
                    __builtin_amdgcn_sched_barrier(0);
                }
            bf16_t* gp = G + (size_t)(u.pm * 256 + ai * 128 + wr * 64 + 4 * fr) * FFH + ca0;
            if (fr != 0) *(u32x4*)(gp) = pk[0];
            *(u32x4*)(gp + FFH) = pk[1];
            *(u32x4*)(gp + 2 * FFH) = pk[2];
            if (fr != 15) *(u32x4*)(gp + 3 * FFH) = pk[3];
        }
    }
};

struct AttnDesc {
    const bf16_t* q; int ldq;
    bf16_t* o; int ldo;
    const bf16_t* k; int ldk;
    const bf16_t* kr; int ldkr;
    const bf16_t* v; int ldv;
    int nloc, loc_row0, ctx_row0;
    int mode;
    int a0, a1, a2;
    float sink;
};
constexpr int ATT_KBUF = 64 * 208, ATT_VOFF = 2 * ATT_KBUF, ATT_RPB = ATT_VOFF + 2 * 8192;
constexpr int ATT2_KSTG = 2 * ATT_KBUF, ATT2_VOFF = 2 * ATT2_KSTG, ATT2_VSTG = 2 * 8192;

__device__ __forceinline__ void attn_unit_mla(LAS unsigned char* lds, const AttnDesc& A, int tid_in, int wid, int lane_in) {
    constexpr int KSTR = (96 + 8) * 2, NS = 6;
    int tid = tid_in; asm volatile("" : "+v"(tid));
    const int lane = tid & 63; (void)lane_in;
    const int r32 = lane & 31, h = lane >> 5;
    const int nt = A.nloc + 4, nstg = nt >> 1;
    bf16x8 qf[NS];
#pragma unroll
    for (int s = 0; s < NS; ++s) qf[s] = *(const bf16x8*)(A.q + (size_t)r32 * A.ldq + 16 * s + 8 * h);
    f32x16 o0, o1;
#pragma unroll
    for (int r = 0; r < 16; ++r) { o0[r] = 0.f; o1[r] = 0.f; }
    float mrun = -1e30f, lrun = 0.f;
    const int skey = tid >> 3, sch = tid & 7;
    u32x4 ka, va, kra = (u32x4){0u, 0u, 0u, 0u}, kb_, vb_, krb = (u32x4){0u, 0u, 0u, 0u};
#define MLA_LOAD(KR, VR, KRR, tt) do { const int t1_ = (tt); const int row0_ = (t1_ < A.nloc) ? A.loc_row0 + 64 * t1_ : A.ctx_row0 + 64 * (t1_ - A.nloc); \
        KR = *(const u32x4*)(A.k + (size_t)(row0_ + skey) * A.ldk + 8 * sch); VR = *(const u32x4*)(A.v + (size_t)(row0_ + skey) * A.ldv + 8 * sch); \
        if (tid < 256) KRR = *(const u32x4*)(A.kr + (size_t)(row0_ + (tid >> 2)) * A.ldkr + 8 * (tid & 3)); } while (0)
#define MLA_STORE(KR, VR, KRR, kbp, vbp) do { *(LAS u32x4*)((kbp) + skey * KSTR + sch * 16) = KR; \
        if (tid < 256) *(LAS u32x4*)((kbp) + (tid >> 2) * KSTR + 128 + (tid & 3) * 16) = KRR; \
        *(LAS u32x4*)((vbp) + (sch >> 2) * 4096 + skey * 64 + (sch & 3) * 16) = VR; } while (0)
    MLA_LOAD(ka, va, kra, 0); MLA_LOAD(kb_, vb_, krb, 1);
    const int vtr_off = ((lane & 15) >> 2) * 64 + (16 * ((lane >> 4) & 1) + 4 * (lane & 3)) * 2 + 4 * h * 64;
#define MLA_VRD0(VA, VC, vbp) do { const LAS unsigned char* vp = (vbp) + vtr_off; \
            const s16x4 a0 = __builtin_bit_cast(s16x4, __builtin_amdgcn_ds_read_tr16_b64_v4i16((LAS s16x4*)(vp))); \
            const s16x4 a1 = __builtin_bit_cast(s16x4, __builtin_amdgcn_ds_read_tr16_b64_v4i16((LAS s16x4*)(vp + 8 * 64))); \
            const s16x4 c0 = __builtin_bit_cast(s16x4, __builtin_amdgcn_ds_read_tr16_b64_v4i16((LAS s16x4*)(vp + 4096))); \
            const s16x4 c1 = __builtin_bit_cast(s16x4, __builtin_amdgcn_ds_read_tr16_b64_v4i16((LAS s16x4*)(vp + 4096 + 8 * 64))); \
            VA = (bf16x8){a0[0], a0[1], a0[2], a0[3], a1[0], a1[1], a1[2], a1[3]}; VC = (bf16x8){c0[0], c0[1], c0[2], c0[3], c1[0], c1[1], c1[2], c1[3]}; } while (0)
    for (int st = 0; st < nstg; ++st) {
        LAS unsigned char* kbuf = lds + (st & 1) * ATT2_KSTG;
        LAS unsigned char* vbuf = lds + ATT2_VOFF + (st & 1) * ATT2_VSTG;
        MLA_STORE(ka, va, kra, kbuf, vbuf); MLA_STORE(kb_, vb_, krb, kbuf + ATT_KBUF, vbuf + 8192);
        __syncthreads();
        if (st + 1 < nstg) { MLA_LOAD(ka, va, kra, 2 * st + 2); MLA_LOAD(kb_, vb_, krb, 2 * st + 3); }
        f32x16 s0, s1, s2, s3;
#pragma unroll
        for (int r = 0; r < 16; ++r) { s0[r] = 0.f; s1[r] = 0.f; s2[r] = 0.f; s3[r] = 0.f; }
        __builtin_amdgcn_s_setprio(1);
        bf16x8 kf[2][4];
#define MLA_KRD(SET, st_) do { const int co_ = (16 * (st_) + 8 * h) * 2; \
            kf[SET][0] = *(const LAS bf16x8*)(kbuf + r32 * KSTR + co_); kf[SET][1] = *(const LAS bf16x8*)(kbuf + (32 + r32) * KSTR + co_); \
            kf[SET][2] = *(const LAS bf16x8*)(kbuf + ATT_KBUF + r32 * KSTR + co_); kf[SET][3] = *(const LAS bf16x8*)(kbuf + ATT_KBUF + (32 + r32) * KSTR + co_); } while (0)
        MLA_KRD(0, 0);
        __builtin_amdgcn_sched_group_barrier(0x100, 4, 0);
#pragma unroll
        for (int s = 0; s < NS; ++s) {
            if (s + 1 < NS) { MLA_KRD((s + 1) & 1, s + 1); __builtin_amdgcn_sched_group_barrier(0x100, 4, 0); }
            s0 = __builtin_amdgcn_mfma_f32_32x32x16_bf16(kf[s & 1][0], qf[s], s0, 0, 0, 0);
            s1 = __builtin_amdgcn_mfma_f32_32x32x16_bf16(kf[s & 1][1], qf[s], s1, 0, 0, 0);
            s2 = __builtin_amdgcn_mfma_f32_32x32x16_bf16(kf[s & 1][2], qf[s], s2, 0, 0, 0);
            s3 = __builtin_amdgcn_mfma_f32_32x32x16_bf16(kf[s & 1][3], qf[s], s3, 0, 0, 0);
            __builtin_amdgcn_sched_group_barrier(0x008, 4, 0);
        }
#undef MLA_KRD
        __builtin_amdgcn_s_setprio(0);
        bf16x8 va0, vc0;
        MLA_VRD0(va0, vc0, vbuf);
        float m0 = fmaxf(fmaxf(s0[0], s1[0]), fmaxf(s2[0], s3[0]));
#pragma unroll
        for (int r = 1; r < 16; ++r) { m0 = fmaxf(fmaxf(m0, s0[r]), s1[r]); m0 = fmaxf(fmaxf(m0, s2[r]), s3[r]); }
        float mx = fmaxf(m0, __shfl_xor(m0, 32));
        if (__builtin_amdgcn_ballot_w64(mx > mrun + 8.0f) != 0ull) {
            const float mnew = fmaxf(mrun, mx);
            const float alpha = __builtin_amdgcn_exp2f(mrun - mnew);
            mrun = mnew; lrun *= alpha;
#pragma unroll
            for (int r = 0; r < 16; ++r) { o0[r] *= alpha; o1[r] *= alpha; }
        }
        float ra = 0.f, rb = 0.f;
#pragma unroll
        for (int r = 0; r < 16; ++r) { s0[r] = __builtin_amdgcn_exp2f(s0[r] - mrun); s1[r] = __builtin_amdgcn_exp2f(s1[r] - mrun); s2[r] = __builtin_amdgcn_exp2f(s2[r] - mrun); s3[r] = __builtin_amdgcn_exp2f(s3[r] - mrun);
            ra += s0[r] + s1[r]; rb += s2[r] + s3[r]; }
        lrun += ra + rb;
#define MLA_PACK(S, q) __builtin_bit_cast(bf16x8, (u32x4){cvt_pk_bf16_m(S[8 * (q) + 0], S[8 * (q) + 1]), cvt_pk_bf16_m(S[8 * (q) + 2], S[8 * (q) + 3]), cvt_pk_bf16_m(S[8 * (q) + 4], S[8 * (q) + 5]), cvt_pk_bf16_m(S[8 * (q) + 6], S[8 * (q) + 7])})
#define MLA_PV(PF, vbp, ks) do { const LAS unsigned char* vp = (vbp) + vtr_off + (ks) * 16 * 64; \
            const s16x4 a0 = __builtin_bit_cast(s16x4, __builtin_amdgcn_ds_read_tr16_b64_v4i16((LAS s16x4*)(vp))); \
            const s16x4 a1 = __builtin_bit_cast(s16x4, __builtin_amdgcn_ds_read_tr16_b64_v4i16((LAS s16x4*)(vp + 8 * 64))); \
            const s16x4 c0 = __builtin_bit_cast(s16x4, __builtin_amdgcn_ds_read_tr16_b64_v4i16((LAS s16x4*)(vp + 4096))); \
            const s16x4 c1 = __builtin_bit_cast(s16x4, __builtin_amdgcn_ds_read_tr16_b64_v4i16((LAS s16x4*)(vp + 4096 + 8 * 64))); \
            const bf16x8 va_ = (bf16x8){a0[0], a0[1], a0[2], a0[3], a1[0], a1[1], a1[2], a1[3]}; \
            const bf16x8 vc_ = (bf16x8){c0[0], c0[1], c0[2], c0[3], c1[0], c1[1], c1[2], c1[3]}; \
            o0 = __builtin_amdgcn_mfma_f32_32x32x16_bf16(va_, PF, o0, 0, 0, 0); o1 = __builtin_amdgcn_mfma_f32_32x32x16_bf16(vc_, PF, o1, 0, 0, 0); } while (0)
        __builtin_amdgcn_s_setprio(1);
#define MLA_VRD(VA, VC, vbp, ks) do { const LAS unsigned char* vp = (vbp) + vtr_off + (ks) * 16 * 64; \
            const s16x4 a0 = __builtin_bit_cast(s16x4, __builtin_amdgcn_ds_read_tr16_b64_v4i16((LAS s16x4*)(vp))); \
            const s16x4 a1 = __builtin_bit_cast(s16x4, __builtin_amdgcn_ds_read_tr16_b64_v4i16((LAS s16x4*)(vp + 8 * 64))); \
            const s16x4 c0 = __builtin_bit_cast(s16x4, __builtin_amdgcn_ds_read_tr16_b64_v4i16((LAS s16x4*)(vp + 4096))); \
            const s16x4 c1 = __builtin_bit_cast(s16x4, __builtin_amdgcn_ds_read_tr16_b64_v4i16((LAS s16x4*)(vp + 4096 + 8 * 64))); \
            VA = (bf16x8){a0[0], a0[1], a0[2], a0[3], a1[0], a1[1], a1[2], a1[3]}; VC = (bf16x8){c0[0], c0[1], c0[2], c0[3], c1[0], c1[1], c1[2], c1[3]}; } while (0)
#define MLA_MM(PF, VA, VC) do { o0 = __builtin_amdgcn_mfma_f32_32x32x16_bf16(VA, PF, o0, 0, 0, 0); o1 = __builtin_amdgcn_mfma_f32_32x32x16_bf16(VC, PF, o1, 0, 0, 0); } while (0)
        { bf16x8 va1, vc1;
          { const bf16x8 p = MLA_PACK(s0, 0); MLA_VRD(va1, vc1, vbuf, 1); MLA_MM(p, va0, vc0); }
          { const bf16x8 p = MLA_PACK(s0, 1); MLA_VRD(va0, vc0, vbuf, 2); MLA_MM(p, va1, vc1); }
          { const bf16x8 p = MLA_PACK(s1, 0); MLA_VRD(va1, vc1, vbuf, 3); MLA_MM(p, va0, vc0); }
          { const bf16x8 p = MLA_PACK(s1, 1); MLA_VRD(va0, vc0, vbuf + 8192, 0); MLA_MM(p, va1, vc1); }
          { const bf16x8 p = MLA_PACK(s2, 0); MLA_VRD(va1, vc1, vbuf + 8192, 1); MLA_MM(p, va0, vc0); }
          { const bf16x8 p = MLA_PACK(s2, 1); MLA_VRD(va0, vc0, vbuf + 8192, 2); MLA_MM(p, va1, vc1); }
          { const bf16x8 p = MLA_PACK(s3, 0); MLA_VRD(va1, vc1, vbuf + 8192, 3); MLA_MM(p, va0, vc0); }
          { const bf16x8 p = MLA_PACK(s3, 1); MLA_MM(p, va1, vc1); } }
        __builtin_amdgcn_s_setprio(0);
    }
#undef MLA_LOAD
#undef MLA_STORE
#undef MLA_PACK
#undef MLA_VRD
#undef MLA_VRD0
#undef MLA_MM
#undef MLA_PV
    const float ltot = lrun + __shfl_xor(lrun, 32);
    const float inv = 1.0f / ltot;
    bf16_t* op = A.o + (size_t)r32 * A.ldo + 4 * h;
#pragma unroll
    for (int g4 = 0; g4 < 4; ++g4) {
        u32x2 w;
        w.x = cvt_pk_bf16_m(o0[4 * g4 + 0] * inv, o0[4 * g4 + 1] * inv); w.y = cvt_pk_bf16_m(o0[4 * g4 + 2] * inv, o0[4 * g4 + 3] * inv);
        *(u32x2*)(op + 8 * g4) = w;
        w.x = cvt_pk_bf16_m(o1[4 * g4 + 0] * inv, o1[4 * g4 + 1] * inv); w.y = cvt_pk_bf16_m(o1[4 * g4 + 2] * inv, o1[4 * g4 + 3] * inv);
        *(u32x2*)(op + 32 + 8 * g4) = w;
    }
    __syncthreads();
}

template <int DQ>
__device__ __forceinline__ void attn_unit(LAS unsigned char* lds, const AttnDesc& A, int tid_in, int wid, int lane_in) {
    constexpr int KSTR = (DQ + 8) * 2, NS = DQ / 16;
    int tid = tid_in; asm volatile("" : "+v"(tid));
    const int lane = tid & 63; (void)lane_in;
    const int r32 = lane & 31, h = lane >> 5;
    const int nt = A.nloc + 4;
    bf16x8 qf[NS];
#pragma unroll
    for (int s = 0; s < NS; ++s) qf[s] = *(const bf16x8*)(A.q + (size_t)r32 * A.ldq + 16 * s + 8 * h);
    f32x16 o0, o1;
#pragma unroll
    for (int r = 0; r < 16; ++r) { o0[r] = 0.f; o1[r] = 0.f; }
    float mrun = -1e30f, lrun = 0.f;
    f32x16 zero16;
#pragma unroll
    for (int r = 0; r < 16; ++r) zero16[r] = 0.f;
    asm volatile("" : "+v"(zero16));
    const int skey = tid >> 3, sch = tid & 7;
    u32x4 kreg, vreg, krreg = (u32x4){0u, 0u, 0u, 0u};
    {
        const int row0 = (0 < A.nloc) ? A.loc_row0 : A.ctx_row0;
        kreg = *(const u32x4*)(A.k + (size_t)(row0 + skey) * A.ldk + 8 * sch);
        vreg = *(const u32x4*)(A.v + (size_t)(row0 + skey) * A.ldv + 8 * sch);
        if (DQ == 96 && tid < 256) krreg = *(const u32x4*)(A.kr + (size_t)(row0 + (tid >> 2)) * A.ldkr + 8 * (tid & 3));
    }
    const LAS float* rpbl = (const LAS float*)(lds + ATT_RPB);
    const int vtr_off = ((lane & 15) >> 2) * 64 + (16 * ((lane >> 4) & 1) + 4 * (lane & 3)) * 2 + 4 * h * 64;
    for (int t = 0; t < nt; ++t) {
        LAS unsigned char* kb = lds + (t & 1) * ATT_KBUF;
        LAS unsigned char* vb = lds + ATT_VOFF + (t & 1) * 8192;
        *(LAS u32x4*)(kb + skey * KSTR + sch * 16) = kreg;
        if (DQ == 96 && tid < 256) *(LAS u32x4*)(kb + (tid >> 2) * KSTR + 128 + (tid & 3) * 16) = krreg;
        *(LAS u32x4*)(vb + (sch >> 2) * 4096 + skey * 64 + (sch & 3) * 16) = vreg;
        __syncthreads();
        if (t + 1 < nt) {
            const int t1 = t + 1;
            const int row0 = (t1 < A.nloc) ? A.loc_row0 + 64 * t1 : A.ctx_row0 + 64 * (t1 - A.nloc);
            kreg = *(const u32x4*)(A.k + (size_t)(row0 + skey) * A.ldk + 8 * sch);
            vreg = *(const u32x4*)(A.v + (size_t)(row0 + skey) * A.ldv + 8 * sch);
            if (DQ == 96 && tid < 256) krreg = *(const u32x4*)(A.kr + (size_t)(row0 + (tid >> 2)) * A.ldkr + 8 * (tid & 3));
        }
        const bool loc = t < A.nloc;
        bool act = true;
        if (A.mode == 1 && loc) { const int kr = A.a0 + t; act = (kr >= A.a2) && (kr < A.a2 + 8); }
        if (act) {
            f32x16 s0, s1;
#pragma unroll
            for (int s = 0; s < NS; ++s) {
                const bf16x8 k0 = *(const LAS bf16x8*)(kb + r32 * KSTR + (16 * s + 8 * h) * 2);
                const bf16x8 k1 = *(const LAS bf16x8*)(kb + (32 + r32) * KSTR + (16 * s + 8 * h) * 2);
                s0 = __builtin_amdgcn_mfma_f32_32x32x16_bf16(k0, qf[s], s == 0 ? zero16 : s0, 0, 0, 0);
                s1 = __builtin_amdgcn_mfma_f32_32x32x16_bf16(k1, qf[s], s == 0 ? zero16 : s1, 0, 0, 0);
            }
            if (loc && A.mode == 1) {
                const int qc = 32 * (wid & 1) + r32;
                const int w0 = min(max(qc - 8, 0), 48);
                const int rbase = (A.a0 + t - A.a1 + 7) * 31;
#pragma unroll
                for (int r = 0; r < 16; ++r) {
                    const int kc = (r & 3) + 8 * (r >> 2) + 4 * h;
                    { const int dc = min(max(kc - qc + 15, 0), 30); const bool ok = (unsigned)(kc - w0) < 16u; const float bv = rpbl[rbase + dc]; s0[r] = ok ? s0[r] + bv : -1e30f; }
                    { const int kc2 = kc + 32; const int dc = min(max(kc2 - qc + 15, 0), 30); const bool ok = (unsigned)(kc2 - w0) < 16u; const float bv = rpbl[rbase + dc]; s1[r] = ok ? s1[r] + bv : -1e30f; }
                }
            } else if (loc && A.mode == 2) {
                const int p0 = A.a0 + 64 * t;
                if (p0 < A.a1 + 31 - 128 || p0 + 63 > A.a1 + 128) {
                    const int dbase = p0 - (A.a1 + r32);
#pragma unroll
                    for (int r = 0; r < 16; ++r) {
                        const int kc = (r & 3) + 8 * (r >> 2) + 4 * h;
                        s0[r] = ((unsigned)(dbase + kc + 128) > 256u) ? -1e30f : s0[r];
                        s1[r] = ((unsigned)(dbase + kc + 32 + 128) > 256u) ? -1e30f : s1[r];
                    }
                }
            }
            float mxa = fmaxf(fmaxf(s0[0], s0[1]), s0[2]), mxb = fmaxf(fmaxf(s1[0], s1[1]), s1[2]);
            mxa = fmaxf(fmaxf(mxa, s0[3]), s0[4]); mxb = fmaxf(fmaxf(mxb, s1[3]), s1[4]);
            mxa = fmaxf(fmaxf(mxa, s0[5]), s0[6]); mxb = fmaxf(fmaxf(mxb, s1[5]), s1[6]);
            mxa = fmaxf(fmaxf(mxa, s0[7]), s0[8]); mxb = fmaxf(fmaxf(mxb, s1[7]), s1[8]);
            mxa = fmaxf(fmaxf(mxa, s0[9]), s0[10]); mxb = fmaxf(fmaxf(mxb, s1[9]), s1[10]);
            mxa = fmaxf(fmaxf(mxa, s0[11]), s0[12]); mxb = fmaxf(fmaxf(mxb, s1[11]), s1[12]);
            mxa = fmaxf(fmaxf(mxa, s0[13]), s0[14]); mxb = fmaxf(fmaxf(mxb, s1[13]), s1[14]);
            float mx = fmaxf(fmaxf(mxa, mxb), fmaxf(s0[15], s1[15]));
            mx = fmaxf(mx, __shfl_xor(mx, 32));
            if (__builtin_amdgcn_ballot_w64(mx > mrun + 8.0f) != 0ull) {
                const float mnew = fmaxf(mrun, mx);
                const float alpha = __builtin_amdgcn_exp2f(mrun - mnew);
                mrun = mnew; lrun *= alpha;
#pragma unroll
                for (int r = 0; r < 16; ++r) { o0[r] *= alpha; o1[r] *= alpha; }
            }
            float rsa = 0.f, rsb = 0.f;
#pragma unroll
            for (int r = 0; r < 16; ++r) { s0[r] = __builtin_amdgcn_exp2f(s0[r] - mrun); s1[r] = __builtin_amdgcn_exp2f(s1[r] - mrun); rsa += s0[r]; rsb += s1[r]; }
            lrun += rsa + rsb;
            bf16x8 pf[4];
#pragma unroll
            for (int s2 = 0; s2 < 2; ++s2) {
                u32x4 w;
                w.x = cvt_pk_bf16_m(s0[8 * s2 + 0], s0[8 * s2 + 1]); w.y = cvt_pk_bf16_m(s0[8 * s2 + 2], s0[8 * s2 + 3]); w.z = cvt_pk_bf16_m(s0[8 * s2 + 4], s0[8 * s2 + 5]); w.w = cvt_pk_bf16_m(s0[8 * s2 + 6], s0[8 * s2 + 7]);
                pf[s2] = __builtin_bit_cast(bf16x8, w);
                w.x = cvt_pk_bf16_m(s1[8 * s2 + 0], s1[8 * s2 + 1]); w.y = cvt_pk_bf16_m(s1[8 * s2 + 2], s1[8 * s2 + 3]); w.z = cvt_pk_bf16_m(s1[8 * s2 + 4], s1[8 * s2 + 5]); w.w = cvt_pk_bf16_m(s1[8 * s2 + 6], s1[8 * s2 + 7]);
                pf[2 + s2] = __builtin_bit_cast(bf16x8, w);
            }
#pragma unroll
            for (int ks = 0; ks < 4; ++ks) {
                const LAS unsigned char* vp = vb + vtr_off + ks * 16 * 64;
                const s16x4 a0 = __builtin_bit_cast(s16x4, __builtin_amdgcn_ds_read_tr16_b64_v4i16((LAS s16x4*)(vp)));
                const s16x4 a1 = __builtin_bit_cast(s16x4, __builtin_amdgcn_ds_read_tr16_b64_v4i16((LAS s16x4*)(vp + 8 * 64)));
                const s16x4 c0 = __builtin_bit_cast(s16x4, __builtin_amdgcn_ds_read_tr16_b64_v4i16((LAS s16x4*)(vp + 4096)));
                const s16x4 c1 = __builtin_bit_cast(s16x4, __builtin_amdgcn_ds_read_tr16_b64_v4i16((LAS s16x4*)(vp + 4096 + 8 * 64)));
                const bf16x8 va = (bf16x8){a0[0], a0[1], a0[2], a0[3], a1[0], a1[1], a1[2], a1[3]};
                const bf16x8 vc = (bf16x8){c0[0], c0[1], c0[2], c0[3], c1[0], c1[1], c1[2], c1[3]};
                o0 = __builtin_amdgcn_mfma_f32_32x32x16_bf16(va, pf[ks], o0, 0, 0, 0);
                o1 = __builtin_amdgcn_mfma_f32_32x32x16_bf16(vc, pf[ks], o1, 0, 0, 0);
            }
        }
    }
    float ltot = lrun + __shfl_xor(lrun, 32);
    ltot += __builtin_amdgcn_exp2f(A.sink - mrun);
    const float inv = 1.0f / ltot;
    bf16_t* op = A.o + (size_t)r32 * A.ldo + 4 * h;
#pragma unroll
    for (int g4 = 0; g4 < 4; ++g4) {
        u32x2 w;
        w.x = cvt_pk_bf16_m(o0[4 * g4 + 0] * inv, o0[4 * g4 + 1] * inv); w.y = cvt_pk_bf16_m(o0[4 * g4 + 2] * inv, o0[4 * g4 + 3] * inv);
        *(u32x2*)(op + 8 * g4) = w;
        w.x = cvt_pk_bf16_m(o1[4 * g4 + 0] * inv, o1[4 * g4 + 1] * inv); w.y = cvt_pk_bf16_m(o1[4 * g4 + 2] * inv, o1[4 * g4 + 3] * inv);
        *(u32x2*)(op + 32 + 8 * g4) = w;
    }
    __syncthreads();
}


#define XB_TMO      128
#define XB_XCNT(j)  (256  + 64 * (j))
#define XB_XSUB(j)  (1280 + 64 * (j))
#define XB_XGEN(j)  (2304 + 64 * (j))
#define XB_TOP      3328
#define XB_TOPGEN   3392
#define XCD_BAR_WORDS 3456
#define XB_SPIN_CAP (1u << 18)
__device__ __forceinline__ unsigned xb_ld(unsigned* p)              { return __hip_atomic_load(p, __ATOMIC_RELAXED, __HIP_MEMORY_SCOPE_AGENT); }
__device__ __forceinline__ unsigned xb_add(unsigned* p, unsigned v) { return __hip_atomic_fetch_add(p, v, __ATOMIC_RELAXED, __HIP_MEMORY_SCOPE_AGENT); }
__device__ __forceinline__ unsigned xb_xcc_id() { return (unsigned)__builtin_amdgcn_s_getreg((3 << 11) | 20) & 0xFu; }
#define XB_SPIN(cond, bar) do { unsigned _sp = 0; while (cond) { __builtin_amdgcn_s_sleep(1); \
    if ((++_sp & 255u) == 0u) { if (xb_ld(&(bar)[XB_TMO])) break; if (_sp > XB_SPIN_CAP) { atomicAdd(&(bar)[XB_TMO], 1u); break; } } } } while (0)
struct XcdBarrier { unsigned* bar; unsigned x; volatile LAS unsigned* st; };
__device__ __forceinline__ XcdBarrier xcd_barrier_post(unsigned* bar, volatile LAS unsigned* st) {
    XcdBarrier b; b.bar = bar; b.x = xb_xcc_id(); b.st = st;
    if (threadIdx.x == 0) (void)xb_add(&bar[XB_XCNT(b.x)], 1u);
    return b;
}
__device__ __forceinline__ void xcd_barrier_complete(unsigned* bar, unsigned x, unsigned& nloc, unsigned& nx) {
    const unsigned G = gridDim.x * gridDim.y * gridDim.z;
    unsigned sum, cnt, mine, sp = 0u;
    for (;;) {
        sum = 0u; cnt = 0u; mine = 0u;
#pragma unroll
        for (unsigned j = 0; j < 16; ++j) { const unsigned c = xb_ld(&bar[XB_XCNT(j)]); sum += c; cnt += (c > 0u) ? 1u : 0u; mine = (j == x) ? c : mine; }
        if (sum == G) break;
        __builtin_amdgcn_s_sleep(1);
        if ((++sp & 255u) == 0u) { if (xb_ld(&bar[XB_TMO])) break; if (sp > XB_SPIN_CAP) { atomicAdd(&bar[XB_TMO], 1u); break; } }
    }
    nloc = mine > 0u ? mine : 1u; nx = cnt > 0u ? cnt : 1u;
}
__device__ __forceinline__ void xcd_barrier(const XcdBarrier& b) {
    asm volatile("s_waitcnt vmcnt(0)" ::: "memory");
    __syncthreads();
    if (threadIdx.x == 0) {
        unsigned* bar = b.bar;
        __builtin_amdgcn_s_waitcnt(0);
        unsigned nloc = b.st[0], nx = b.st[1];
        if (nloc == 0u) { xcd_barrier_complete(bar, b.x, nloc, nx); b.st[0] = nloc; b.st[1] = nx; }
        const unsigned old = xb_add(&bar[XB_XSUB(b.x)], 1u);
        const unsigned gen = old / nloc;
        if (old + 1u == (gen + 1u) * nloc) {
            __builtin_amdgcn_fence(__ATOMIC_RELEASE, "agent");
            asm volatile("s_waitcnt vmcnt(0)" ::: "memory");
            const unsigned og = xb_add(&bar[XB_TOP], 1u);
            const unsigned tg = og / nx;
            if (og + 1u == (tg + 1u) * nx) xb_add(&bar[XB_TOPGEN], 1u);
            else XB_SPIN(xb_ld(&bar[XB_TOPGEN]) == tg, bar);
            __builtin_amdgcn_fence(__ATOMIC_ACQUIRE, "agent");
            xb_add(&bar[XB_XGEN(b.x)], 1u);
            asm volatile("s_waitcnt vmcnt(0)" ::: "memory");
        } else {
            XB_SPIN(xb_ld(&bar[XB_XGEN(b.x)]) == gen, bar);
            __builtin_amdgcn_fence(__ATOMIC_ACQUIRE, "agent");
            asm volatile("s_waitcnt vmcnt(0)" ::: "memory");
        }
    }
    __syncthreads();
}
constexpr int LDS_BARST = 131072 + 10240;

struct Args { const float* in[22]; float* out; unsigned char* ws; int ph_lo, ph_hi; };
enum { IN_X = 0, IN_C, IN_CTX, IN_CCTX, IN_WADA, IN_BADA, IN_RPB, IN_WINE, IN_QNORM, IN_WUQ, IN_KVNORM, IN_WUKV, IN_WOUTE, IN_WINO, IN_SINKS, IN_WOUTO, IN_WUP, IN_BUP, IN_CONVW, IN_CONVB, IN_WDOWN, IN_BDOWN };
constexpr int N_PHASES = 2 + 11 + 10 + 11 + 8;

__device__ __forceinline__ float wave_sum(float v) {
#pragma unroll
    for (int o = 1; o < 64; o <<= 1) v += __shfl_xor(v, o);
    return v;
}

__device__ __forceinline__ void conv_item(const float* W, int K, int N, int Np, bf16_t* WT, const float* kscale, int mapmode, LAS float* scr, int item, int lane) {
    const int nblk = Np / 64, kb = item / nblk, nb = item % nblk, k0 = 64 * kb, n0 = 64 * nb;
    int src0 = n0;
    if (mapmode == 1) { const int tl = n0 >> 8, i = n0 & 255; src0 = (i < 128) ? (128 * tl + i) : (FFH + 128 * tl + (i - 128)); }
    const int c4 = 4 * (lane & 15);
    const bool valid = (mapmode == 1) || (n0 + c4 < N);
#pragma unroll 8
    for (int j = 0; j < 16; ++j) { const int kk = 4 * j + (lane >> 4);
        f32x4 v = (f32x4){0.f, 0.f, 0.f, 0.f};
        if (valid) { v = *(const f32x4*)(W + (size_t)(k0 + kk) * N + src0 + c4); if (kscale) v = v * kscale[k0 + kk]; }
        LAS float* d = scr + kk * 65 + c4; d[0] = v[0]; d[1] = v[1]; d[2] = v[2]; d[3] = v[3]; }
    const int c = lane & 7;
#pragma unroll
    for (int j = 0; j < 8; ++j) { const int n = (lane >> 3) + 8 * j; const LAS float* sp = scr + (8 * c) * 65 + n;
        u32x4 o; o.x = cvt_pk_bf16(sp[0 * 65], sp[1 * 65]); o.y = cvt_pk_bf16(sp[2 * 65], sp[3 * 65]); o.z = cvt_pk_bf16(sp[4 * 65], sp[5 * 65]); o.w = cvt_pk_bf16(sp[6 * 65], sp[7 * 65]);
        *(u32x4*)(WT + (size_t)(n0 + n) * K + k0 + 8 * c) = o; }
}

__device__ __forceinline__ void sincos_d(double a, float& c, float& s) {
    const double twopi = 6.283185307179586476925;
    const double k = __builtin_rint(a / twopi);
    const double r = a - k * twopi;
    const double r2 = r * r;
    double cs = 1.0, sn = r, tc = 1.0, ts = r;
#pragma unroll 1
    for (int i = 1; i <= 14; ++i) { tc = -tc * r2 / (double)((2 * i - 1) * (2 * i)); ts = -ts * r2 / (double)((2 * i) * (2 * i + 1)); cs += tc; sn += ts; }
    c = (float)cs; s = (float)sn;
}

__global__ void __launch_bounds__(512, 2) mk_fwd(Args args) {
    extern __shared__ __attribute__((aligned(16))) unsigned char lds_raw[];
    LAS unsigned char* lds = (LAS unsigned char*)lds_raw;
    const int G = gridDim.x, NGW = G * 8;
    cg::grid_group grid = cg::this_grid();
    if (threadIdx.x == 0) { ((volatile LAS unsigned*)(lds + LDS_BARST))[0] = 0u; ((volatile LAS unsigned*)(lds + LDS_BARST))[1] = 0u; }
    __syncthreads();
    const XcdBarrier xbar = xcd_barrier_post((unsigned*)args.ws, (volatile LAS unsigned*)(lds + LDS_BARST));

    for (int ph = args.ph_lo; ph < args.ph_hi; ++ph) {
        unsigned char* ws = args.ws; asm volatile("" : "+s"(ws));
        float* MODS = (float*)(ws + WS_MODS);
        float* tabM = (float*)(ws + WS_TAB); float* tabS = tabM + 1024;
        float* XC = (float*)(ws + WS_XC); float* XL = args.out;
        bf16_t* WB = (bf16_t*)(ws + WS_W);
        bf16_t* HO = (bf16_t*)(ws + WS_HO);
        bf16_t* Z = (bf16_t*)(ws + WS_Z);
        bf16_t* Q2 = (bf16_t*)(ws + WS_Q2);
        bf16_t* KV2 = (bf16_t*)(ws + WS_KV2);
        bf16_t* GB = (bf16_t*)(ws + WS_G);
        float* HALO = (float*)(ws + WS_HALO);
        float* STAT = (float*)(ws + WS_STAT);
        float* SSQ = (float*)(ws + WS_SSQ);
        int l = 0, kind = 100 + ph;
        if (ph >= 2) {
            const unsigned long long SEQ_E = 0x0ull | (1ull << 4) | (2ull << 8) | (3ull << 12) | (4ull << 16) | (9ull << 20) | (5ull << 24) | (6ull << 28) | (7ull << 32) | (8ull << 36) | (10ull << 40);
            const unsigned long long SEQ_O = 0x0ull | (2ull << 4) | (3ull << 8) | (4ull << 12) | (9ull << 16) | (5ull << 20) | (6ull << 24) | (7ull << 28) | (8ull << 32) | (10ull << 36);
            const unsigned long long SEQ_L = 0x0ull | (2ull << 4) | (3ull << 8) | (4ull << 12) | (5ull << 16) | (6ull << 20) | (7ull << 24) | (8ull << 28);
            unsigned long long seq; int pos;
            if (ph < 13) { l = 0; seq = SEQ_E; pos = ph - 2; } else if (ph < 23) { l = 1; seq = SEQ_O; pos = ph - 13; } else if (ph < 34) { l = 2; seq = SEQ_E; pos = ph - 23; } else { l = 3; seq = SEQ_L; pos = ph - 34; }
            kind = (int)((seq >> (4 * pos)) & 15ull);
        }
        int cv_lo = 0, cv_hi = 0, cv_w = 0, cv_n = 1;
        if (ph == 0 && EN(100)) {
            GET_TID();
            for (int it = blockIdx.x; it < 768; it += G) {
                const int l = it / 192, col0 = (it % 192) * 32, d0 = wid * 128;
                LAS float* sc = (LAS float*)(lds + wid * 10240);
                for (int b = 0; b < 17; ++b)
#pragma unroll
                    for (int hh = 0; hh < 2; ++hh) { const int dd = lane + 64 * hh; const float x = (b < 16) ? args.in[IN_C][b * 1024 + d0 + dd] : args.in[IN_CCTX][d0 + dd]; sc[b * 128 + dd] = x / (1.0f + __expf(-x)); }
                float acc[17];
#pragma unroll
                for (int b = 0; b < 17; ++b) acc[b] = 0.f;
                const int hi = lane >> 5, cc = lane & 31;
                const float* wp = args.in[IN_WADA] + ((size_t)(l * 1024 + d0 + hi)) * 6144 + col0 + cc;
#pragma unroll 16
                for (int i = 0; i < 64; ++i) { const float w = wp[(size_t)(2 * i) * 6144];
#pragma unroll
                    for (int b = 0; b < 17; ++b) acc[b] += sc[b * 128 + 2 * i + hi] * w; }
                LAS float* red = (LAS float*)(lds + 81920);
#pragma unroll
                for (int b = 0; b < 17; ++b) { const float t = acc[b] + __shfl_xor(acc[b], 32); if (hi == 0) red[(wid * 17 + b) * 32 + cc] = t; }
                __syncthreads();
                for (int x = tid; x < 17 * 32; x += 512) { const int b = x >> 5, c2 = x & 31; float sm = args.in[IN_BADA][l * 6144 + col0 + c2];
#pragma unroll
                    for (int w = 0; w < 8; ++w) sm += red[(w * 17 + b) * 32 + c2];
                    MODS[(size_t)(l * 17 + b) * 6144 + col0 + c2] = sm; }
                __syncthreads();
            }
            if (blockIdx.x == G - 1) {
                for (int x = tid; x < 64 * 8 + 64 * 16; x += 512) {
                    const bool isM = x < 512; const int y = isM ? x : x - 512; const int nf = isM ? 8 : 16; const int pos = y / nf, f = y % nf;
                    const double base = isM ? 0.31622776601683794 : 0.5623413251903491;
                    double inv = 1.0; for (int i = 0; i < f; ++i) inv *= base;
                    const float ang = (float)pos * (float)inv;
                    float c, s; sincos_d((double)ang, c, s);
                    float* tp = isM ? tabM : tabS; tp[2 * y] = c; tp[2 * y + 1] = s;
                }
            }
            cv_lo = 0; cv_hi = 1; cv_w = gw; cv_n = NGW;
        } else if (ph == 1 && EN(101)) {
            GET_TID();
            for (int row = gw; row < MT; row += NGW) {
                const bool lat = row < ML;
                const float* xr = lat ? args.in[IN_X] + (size_t)row * DM : args.in[IN_CTX] + (size_t)(row - ML) * DM;
                const float* mp = MODS + (size_t)(lat ? (row >> 11) : 16) * 6144;
#pragma unroll
                for (int j = 0; j < 4; ++j) { const int col = 4 * lane + 256 * j;
                    const f32x4 v = *(const f32x4*)(xr + col), sh = *(const f32x4*)(mp + col), sc = *(const f32x4*)(mp + 1024 + col);
                    const f32x4 hv = v * (sc + 1.0f) + sh;
                    u32x2 w; w.x = cvt_pk_bf16(hv[0], hv[1]); w.y = cvt_pk_bf16(hv[2], hv[3]);
                    *(u32x2*)(HO + (size_t)row * DM + col) = w; }
            }
        } else {
            const int li = l >> 1; const bool even = !(l & 1); const bool with_ctx = l < 3;
            const float* modl = MODS + (size_t)l * 17 * 6144;
            const int Mrows = with_ctx ? MT : ML;
            if (kind == 0 && EN(0)) {
                pg8::Gemm g{HO, WB + w_win(l), MT, even ? ZE : ZO, DM, DM}; pg8::StaticOrder S; S.init(MT, g.N, G, (int)blockIdx.x);
                EpiZ E{Z, even ? ZE : ZO, even ? 0 : 1, tabM, tabS, SSQ};
                pg8::gemm_phase<EpiZ>(lds, g, S, E);
            } else if (kind == 1 && EN(1)) {
                for (int which = 0; which < 2; ++which) {
                    pg8::Gemm g; EpiQK E;
                    if (which == 0) { g = pg8::Gemm{Z + 1536, WB + w_uq(l), MT, 768, 384, ZE}; E = EpiQK{Q2, 768, SSQ, 12, 1.0f / 384.0f, 1, tabM}; }
                    else { g = pg8::Gemm{Z + 1920, WB + w_ukv(l), MT, 1024, 256, ZE}; E = EpiQK{KV2, 1024, SSQ + 12, 8, 1.0f / 256.0f, 0, tabM}; }
                    pg8::StaticOrder S; S.init(MT, g.N, G, (int)blockIdx.x);
                    pg8::gemm_phase<EpiQK>(lds, g, S, E);
                }
            } else if (kind == 2 && EN(2)) {
                GET_TID();
                const int nunits = with_ctx ? 2304 : 2048;
                LAS float* rpbl = (LAS float*)(lds + ATT_RPB);
                const int vblk = (G % 8 == 0) ? (int)(blockIdx.x % 8) * (G / 8) + (int)(blockIdx.x / 8) : (int)blockIdx.x;
                for (int ui = vblk; ui < nunits; ui += G) {
                    AttnDesc A; bool dq96 = false;
                    A.sink = -1e30f; A.mode = 0; A.a0 = 0; A.a1 = 0; A.a2 = 0; A.kr = Z; A.ldkr = 0; A.nloc = 0; A.loc_row0 = 0;
                    if (even) {
                        if (ui < 1024 || (ui >= 2048 && ui < 2176)) {
                            dq96 = true; int b, hh, qrow;
                            if (ui < 1024) { b = ui >> 6; hh = (ui >> 3) & 7; qrow = b * 2048 + 256 * (ui & 7); A.nloc = 32; A.loc_row0 = b * 2048; }
                            else { const int j = ui - 2048; b = j >> 3; hh = j & 7; qrow = ML + b * 256; }
                            qrow += 32 * wid; A.ctx_row0 = ML + b * 256;
                            A.q = Q2 + (size_t)qrow * 768 + 96 * hh; A.ldq = 768;
                            A.o = HO + (size_t)qrow * DM + 512 + 64 * hh; A.ldo = DM;
                            A.k = KV2 + 128 * hh; A.ldk = 1024; A.kr = Z + 2176; A.ldkr = ZE; A.v = KV2 + 128 * hh + 64; A.ldv = 1024;
                        } else {
                            int b, hh, qrow;
                            if (ui < 2048) { const int j = ui - 1024; b = j >> 6; hh = (j >> 3) & 7; const int R4 = j & 7; qrow = b * 2048 + 256 * R4;
                                const int lo = min(max(4 * R4 - 4, 0), 24), hi = min(max(4 * R4 - 1, 0), 24) + 8;
                                A.nloc = hi - lo; A.loc_row0 = b * 2048 + 64 * lo; A.mode = 1; A.a0 = lo; A.a1 = 4 * R4 + (wid >> 1); A.a2 = min(max(A.a1 - 4, 0), 24);
                                for (int x = tid; x < 465; x += 512) rpbl[x] = args.in[IN_RPB][(size_t)(li * 8 + hh) * 465 + x] * LOG2E;
                            } else { const int j = ui - 2176; b = j >> 3; hh = j & 7; qrow = ML + b * 256; }
                            qrow += 32 * wid; A.ctx_row0 = ML + b * 256;
                            A.q = Z + (size_t)qrow * ZE + 64 * hh; A.ldq = ZE; A.o = HO + (size_t)qrow * DM + 64 * hh; A.ldo = DM;
                            A.k = Z + 512 + 64 * hh; A.ldk = ZE; A.v = Z + 1024 + 64 * hh; A.ldv = ZE;
                        }
                    } else {
                        int b, qh, kvh, qrow;
                        if (ui < 2048) { b = ui >> 7; kvh = (ui >> 6) & 1; const int tb = ui & 63; const int q0 = 32 * tb; qh = 8 * kvh + wid; qrow = b * 2048 + q0;
                            const int ks64 = ((q0 - 128) >> 6) << 6;
                            const int tlo = ks64 < 0 ? (-ks64) >> 6 : 0; int thi = (2048 - ks64) >> 6; if (thi > 5) thi = 5;
                            A.nloc = thi - tlo; const int pos0 = ks64 + 64 * tlo; A.loc_row0 = b * 2048 + pos0; A.mode = 2; A.a0 = pos0; A.a1 = q0;
                        } else { const int j = ui - 2048; b = j >> 4; qh = j & 15; kvh = qh >> 3; qrow = ML + b * 256 + 32 * wid; }
                        A.ctx_row0 = ML + b * 256;
                        A.sink = args.in[IN_SINKS][li * 16 + qh] * LOG2E;
                        A.q = Z + (size_t)qrow * ZO + 64 * qh; A.ldq = ZO; A.o = HO + (size_t)qrow * DM + 64 * qh; A.ldo = DM;
                        A.k = Z + 1024 + 64 * kvh; A.ldk = ZO; A.v = Z + 1152 + 64 * kvh; A.ldv = ZO;
                    }
                    if (dq96) attn_unit_mla(lds, A, tid, wid, lane); else attn_unit<64>(lds, A, tid, wid, lane);
                }
            } else if ((kind == 3 || kind == 7 || ((kind == 4 || kind == 8) && with_ctx && (blockIdx.x & 3) == 0)) && EN(3)) {
                const bool ctxpart = (kind == 4 || kind == 8);
                const bool isout = (kind == 3 || kind == 4);
                pg8::Gemm g; EpiRes E;
                const float* sL = (l == 0 && isout) ? args.in[IN_X] : XL; const float* sC = (l == 0 && isout) ? args.in[IN_CTX] : XC;
                if (isout) { g = pg8::Gemm{HO, WB + w_wout(l), MT, DM, DM, DM}; E = EpiRes{sL, sC, XL, XC, modl + 2048, nullptr, (l == 0) ? nullptr : STAT}; }
                else { g = pg8::Gemm{GB, WB + w_down(l), MT, DM, FFH, FFH}; E = EpiRes{sL, sC, XL, XC, modl + 5120, args.in[IN_BDOWN] + l * 1024, STAT}; }
                pg8::StaticOrder S;
                if (ctxpart) S.init(MC, DM, G / 4, (int)(blockIdx.x >> 2), ML / 256); else S.init(ML, DM, G, (int)blockIdx.x);
                pg8::gemm_phase<EpiRes>(lds, g, S, E);
            } else if ((kind == 4 || kind == 8 || kind == 9 || kind == 10) && EN(4)) {
                GET_TID();
                const bool first = (kind == 4 || kind == 9);
                const bool lastln = (l == 3 && kind == 8);
                const float* mp0 = first ? modl + 3072 : (lastln ? modl : modl + 17 * 6144);
                int rbeg = 0, rend = ML, wstart = gw, wstride = NGW;
                if (kind == 9 || kind == 10) { rbeg = ML; rend = MT; }
                else if (with_ctx) { const int bi = (int)blockIdx.x - (int)(blockIdx.x >> 2) - 1; wstart = bi * 8 + wid; wstride = (G - G / 4) * 8; }
                auto ln_row = [&](const int row, f32x4 (&v)[4]) __attribute__((always_inline)) {
                    const bool lat = row < ML;
                    float* xr = lat ? XL + (size_t)row * DM : XC + (size_t)(row - ML) * DM;
                    const float* mp = mp0 + (size_t)(lat ? (row >> 11) : 16) * 6144;
                    float s = 0.f;
#pragma unroll
                    for (int j = 0; j < 4; ++j) s += (v[j][0] + v[j][1]) + (v[j][2] + v[j][3]);
                    const float mean = wave_sum(s) * (1.0f / DM); float s2 = 0.f;
#pragma unroll
                    for (int j = 0; j < 4; ++j) { v[j] = v[j] - mean; s2 += (v[j][0] * v[j][0] + v[j][1] * v[j][1]) + (v[j][2] * v[j][2] + v[j][3] * v[j][3]); }
                    const float rstd = 1.0f / sqrtf(wave_sum(s2) * (1.0f / DM) + LN_EPS);
                    if (lane == 0) { STAT[2 * (size_t)row] = mean; STAT[2 * (size_t)row + 1] = rstd; }
#pragma unroll
                    for (int j = 0; j < 4; ++j) { const int col = 4 * lane + 256 * j; const f32x4 y = v[j] * rstd;
                        if (lastln) *(f32x4*)(xr + col) = y;
                        if (!lastln) { const f32x4 sh = *(const f32x4*)(mp + col), sc = *(const f32x4*)(mp + 1024 + col); const f32x4 hv = y * (sc + 1.0f) + sh;
                            u32x2 w; w.x = cvt_pk_bf16(hv[0], hv[1]); w.y = cvt_pk_bf16(hv[2], hv[3]); *(u32x2*)(HO + (size_t)row * DM + col) = w; } }
                };
                for (int row0 = rbeg + wstart; row0 < rend; row0 += 2 * wstride) {
                    const int row1 = row0 + wstride; const bool has1 = row1 < rend;
                    f32x4 va[4], vb[4];
#pragma unroll
                    for (int j = 0; j < 4; ++j) vb[j] = (f32x4){0.f, 0.f, 0.f, 0.f};
                    { const float* xp = (row0 < ML) ? XL + (size_t)row0 * DM : XC + (size_t)(row0 - ML) * DM;
#pragma unroll
                      for (int j = 0; j < 4; ++j) va[j] = *(const f32x4*)(xp + 4 * lane + 256 * j); }
                    if (has1) { const float* xp = (row1 < ML) ? XL + (size_t)row1 * DM : XC + (size_t)(row1 - ML) * DM;
#pragma unroll
                      for (int j = 0; j < 4; ++j) vb[j] = *(const f32x4*)(xp + 4 * lane + 256 * j); }
                    ln_row(row0, va);
                    if (has1) ln_row(row1, vb);
                }
                if (kind == 8 && with_ctx) { cv_lo = l + 1; cv_hi = l + 2; cv_w = wstart; cv_n = wstride; }
            } else if (kind == 5 && EN(5)) {
                pg8::Gemm g{HO, WB + w_up(l), Mrows, FF2, DM, DM}; pg8::StaticOrder S; S.init(Mrows, FF2, G, (int)blockIdx.x);
                EpiUp E{GB, HALO, args.in[IN_BUP] + (size_t)l * FF2, args.in[IN_CONVW] + (size_t)l * 3 * FF2, args.in[IN_CONVB] + (size_t)l * FF2, (LAS float*)(lds + 131072)};
                pg8::gemm_phase<EpiUp>(lds, g, S, E);
            } else if (kind == 6 && EN(6)) {
                GET_TID();
                const int nitems = (Mrows / 64) * 2;
                const float* bup = args.in[IN_BUP]; (void)bup;
                const float* cw = args.in[IN_CONVW] + (size_t)l * 3 * FF2; const float* cb = args.in[IN_CONVB] + (size_t)l * FF2;
                for (int it = gw; it < nitems * 11; it += NGW) {
                    const int ri = it / 11, chunk = it - ri * 11;
                    const int g64 = ri >> 1, which = ri & 1; const int row = 64 * g64 + (which ? 63 : 0);
                    const int tpos = row < ML ? (row & 2047) : ((row - ML) & 255); const int tlen = row < ML ? 2048 : 256;
                    const float* hc = HALO + (size_t)(g64 * 4 + (which ? 3 : 0)) * FF2;
                    const float* hp = which ? HALO + (size_t)(g64 * 4 + 2) * FF2 : (tpos > 0 ? HALO + (size_t)((g64 - 1) * 4 + 3) * FF2 : nullptr);
                    const float* hn = which ? (tpos < tlen - 1 ? HALO + (size_t)((g64 + 1) * 4 + 0) * FF2 : nullptr) : HALO + (size_t)(g64 * 4 + 1) * FF2;
                    const int c = 256 * chunk + 4 * lane;
                    const int na = ((c >> 7) << 8) + (c & 127), ng = na + 128;
                    const f32x4 z4 = (f32x4){0.f, 0.f, 0.f, 0.f};
                    const f32x4 ac = *(const f32x4*)(hc + na), gc = *(const f32x4*)(hc + ng);
                    const f32x4 ap = hp ? *(const f32x4*)(hp + na) : z4, gp = hp ? *(const f32x4*)(hp + ng) : z4;
                    const f32x4 an = hn ? *(const f32x4*)(hn + na) : z4, gn = hn ? *(const f32x4*)(hn + ng) : z4;
                    const f32x4 av = *(const f32x4*)(cw + c) * ap + *(const f32x4*)(cw + FF2 + c) * ac + *(const f32x4*)(cw + 2 * FF2 + c) * an + *(const f32x4*)(cb + c);
                    const f32x4 gv = *(const f32x4*)(cw + FFH + c) * gp + *(const f32x4*)(cw + FF2 + FFH + c) * gc + *(const f32x4*)(cw + 2 * FF2 + FFH + c) * gn + *(const f32x4*)(cb + FFH + c);
                    f32x4 o;
#pragma unroll
                    for (int e = 0; e < 4; ++e) o[e] = av[e] * gv[e] / (1.0f + __expf(-gv[e]));
                    u32x2 w; w.x = cvt_pk_bf16(o[0], o[1]); w.y = cvt_pk_bf16(o[2], o[3]);
                    *(u32x2*)(GB + (size_t)row * FFH + c) = w;
                }
            }
        }
        if (cv_hi > cv_lo) {
            int tid2 = threadIdx.x; asm volatile("" : "+v"(tid2));
            const int lane2 = tid2 & 63, wid2 = __builtin_amdgcn_readfirstlane(tid2 >> 6);
            LAS float* scr = (LAS float*)(lds + wid2 * 16640);
            int base = 0;
            for (int l2 = cv_lo; l2 < cv_hi; ++l2) {
                const int i = l2 >> 1; const bool even2 = !(l2 & 1);
                for (int kd = 0; kd < 6; ++kd) {
                    const float* W; int K, N, Np, mapmode = 0; const float* ks = nullptr; size_t dst;
                    if (kd == 0) { if (even2) { W = args.in[IN_WINE] + (size_t)i * 1024 * 2208; K = 1024; N = 2208; Np = ZE; } else { W = args.in[IN_WINO] + (size_t)i * 1024 * 1280; K = 1024; N = 1280; Np = ZO; } dst = w_win(l2); }
                    else if (kd == 1) { if (!even2) continue; W = args.in[IN_WUQ] + (size_t)i * 384 * 768; K = 384; N = 768; Np = 768; ks = args.in[IN_QNORM] + i * 384; dst = w_uq(l2); }
                    else if (kd == 2) { if (!even2) continue; W = args.in[IN_WUKV] + (size_t)i * 256 * 1024; K = 256; N = 1024; Np = 1024; ks = args.in[IN_KVNORM] + i * 256; dst = w_ukv(l2); }
                    else if (kd == 3) { W = (even2 ? args.in[IN_WOUTE] : args.in[IN_WOUTO]) + (size_t)i * 1024 * 1024; K = 1024; N = 1024; Np = 1024; dst = w_wout(l2); }
                    else if (kd == 4) { W = args.in[IN_WUP] + (size_t)l2 * 1024 * FF2; K = 1024; N = FF2; Np = FF2; mapmode = 1; dst = w_up(l2); }
                    else { W = args.in[IN_WDOWN] + (size_t)l2 * FFH * 1024; K = FFH; N = 1024; Np = 1024; dst = w_down(l2); }
                    const int nitems = (K / 64) * (Np / 64);
                    int first = (cv_w - base) % cv_n; if (first < 0) first += cv_n;
                    for (int it = first; it < nitems; it += cv_n) conv_item(W, K, N, Np, WB + dst, ks, mapmode, scr, it, lane2);
                    base += nitems;
                }
            }
        }
        for (int xs = 0; xs < PROBE_XSYNC; ++xs) xcd_barrier(xbar);
        if (ph + 1 < args.ph_hi) { if (ph == 0) grid.sync(); else xcd_barrier(xbar); }
    }
}

extern "C" void kernel_launch(void* const* d_in, const int* in_sizes, int n_in, void* d_out, int out_size, void* d_ws, size_t ws_size, hipStream_t stream) {
    static int grid = 0;
    if (grid == 0) {
        if (n_in != 22 || ws_size < WS_END) { fprintf(stderr, "kernel_launch: unexpected inputs (n_in %d, ws %zu)\n", n_in, ws_size); grid = -1; return; }
        int dev = 0, cus = 0, per_cu = 0;
        hipGetDevice(&dev); hipDeviceGetAttribute(&cus, hipDeviceAttributeMultiprocessorCount, dev);
        hipFuncSetAttribute((const void*)mk_fwd, hipFuncAttributeMaxDynamicSharedMemorySize, LDS_BYTES);
        hipOccupancyMaxActiveBlocksPerMultiprocessor(&per_cu, (const void*)mk_fwd, 512, LDS_BYTES);
        if (per_cu < 1) { fprintf(stderr, "kernel_launch: occupancy query says %d blocks/CU\n", per_cu); per_cu = 1; }
        (void)hipGetLastError();
        grid = cus;
    }
    if (grid < 0) return;
    if (hipMemsetAsync(d_ws, 0, 16384, stream) != hipSuccess) { fprintf(stderr, "kernel_launch: memset failed\n"); return; }
    Args a{};
    for (int i = 0; i < 22; ++i) a.in[i] = (const float*)d_in[i];
    a.out = (float*)d_out; a.ws = (unsigned char*)d_ws;
#if MK_PER_PHASE_LAUNCH
    for (int ph = 0; ph < N_PHASES; ++ph) { a.ph_lo = ph; a.ph_hi = ph + 1; hipLaunchKernelGGL(mk_fwd, dim3(grid), dim3(512), LDS_BYTES, stream, a); }
#else
    a.ph_lo = 0; a.ph_hi = N_PHASES;
    void* kargs[] = {&a};
    hipError_t e = hipLaunchCooperativeKernel((const void*)mk_fwd, dim3(grid), dim3(512), kargs, LDS_BYTES, stream);
    if (e != hipSuccess) fprintf(stderr, "cooperative launch failed: %s (grid %d)\n", hipGetErrorString(e), grid);
#endif
}
```

```cpp
#include <hip/hip_runtime.h>
#include <hip/hip_cooperative_groups.h>
#include <cstdint>
#include <cstdio>
namespace cg = cooperative_groups;

#ifndef MK_PER_PHASE_LAUNCH
#define MK_PER_PHASE_LAUNCH 0
#endif

#define LAS __attribute__((address_space(3)))
#define GET_TID() int tid_ = threadIdx.x; asm volatile("" : "+v"(tid_)); const int tid = tid_, lane = tid & 63, wid = __builtin_amdgcn_readfirstlane(tid >> 6); const int gw = blockIdx.x * 8 + wid; (void)gw; (void)lane; (void)tid
#ifdef ONLY
#define EN(x) ((x) == ONLY)
#else
#define EN(x) true
#endif
typedef unsigned short bf16_t;
typedef short bf16x8 __attribute__((ext_vector_type(8)));
typedef short s16x4 __attribute__((ext_vector_type(4)));
typedef float f32x4 __attribute__((ext_vector_type(4)));
typedef float f32x16 __attribute__((ext_vector_type(16)));
typedef unsigned u32x4 __attribute__((ext_vector_type(4)));
typedef unsigned u32x2 __attribute__((ext_vector_type(2)));

constexpr int DM = 1024, NBATCH = 16, SEQL = 2048, CTXL = 256;
constexpr int ML = NBATCH * SEQL;
constexpr int MC = NBATCH * CTXL;
constexpr int MT = ML + MC;
constexpr int ZE = 2304, ZO = 1280, FFH = 2816, FF2 = 5632;
constexpr float LOG2E = 1.4426950408889634f;
constexpr float QS64 = 0.125f * LOG2E;
constexpr float QS96 = 0.10206207261596575f * LOG2E;
constexpr float ALPHA = 1.681792830507429f;
constexpr float LN_EPS = 1e-6f, RMS_EPS = 1e-6f;

constexpr size_t MiB = 1u << 20;
constexpr size_t WS_MODS = 1 * MiB;
constexpr size_t WS_TAB = 3 * MiB;
constexpr size_t WS_XC = 4 * MiB;
constexpr size_t WS_W = 20 * MiB;
constexpr size_t WS_HO = 112 * MiB;
constexpr size_t WS_Z = 184 * MiB;
constexpr size_t WS_Q2 = 346 * MiB;
constexpr size_t WS_KV2 = 400 * MiB;
constexpr size_t WS_G = WS_Z;
constexpr size_t WS_HALO = WS_KV2;
constexpr size_t WS_STAT = 472 * MiB;
constexpr size_t WS_SSQ = 473 * MiB;
constexpr size_t WS_END = 476 * MiB;

constexpr size_t W_EVEN = 2359296 + 294912 + 262144 + 1048576;
constexpr size_t W_ODD = 1310720 + 1048576;
constexpr size_t W_FFN = 5767168 + 2883584;
__host__ __device__ constexpr size_t w_layer_off(int l) { return (size_t)(l / 2) * (W_EVEN + W_ODD) + (size_t)l * W_FFN + ((l & 1) ? W_EVEN : 0); }
__host__ __device__ constexpr size_t w_win(int l) { return w_layer_off(l); }
__host__ __device__ constexpr size_t w_uq(int l) { return w_layer_off(l) + 2359296; }
__host__ __device__ constexpr size_t w_ukv(int l) { return w_layer_off(l) + 2359296 + 294912; }
__host__ __device__ constexpr size_t w_wout(int l) { return w_layer_off(l) + ((l & 1) ? 1310720 : (2359296 + 294912 + 262144)); }
__host__ __device__ constexpr size_t w_up(int l) { return w_wout(l) + 1048576; }
__host__ __device__ constexpr size_t w_down(int l) { return w_up(l) + 5767168; }
static_assert(w_down(3) + 2883584 == 47251456, "weight map");
static_assert(WS_W + 47251456ull * 2 <= WS_HO, "weight region");

constexpr int LDS_BYTES = 147456;
constexpr int PROBE_KIND = -1;
constexpr int PROBE_XSYNC = 0;

__device__ __forceinline__ unsigned cvt_pk_bf16(float lo, float hi) { unsigned r; asm("v_cvt_pk_bf16_f32 %0, %1, %2" : "=v"(r) : "v"(lo), "v"(hi)); return r; }
typedef float f32x2_cv __attribute__((ext_vector_type(2))); typedef __bf16 bf16x2_cv __attribute__((ext_vector_type(2)));
__device__ __forceinline__ unsigned cvt_pk_bf16_m(float lo, float hi) { const f32x2_cv v = {lo, hi}; const bf16x2_cv b = __builtin_convertvector(v, bf16x2_cv); return __builtin_bit_cast(unsigned, b); }
__device__ __forceinline__ float bf_lo(unsigned w) { return __uint_as_float(w << 16); }
__device__ __forceinline__ float bf_hi(unsigned w) { return __uint_as_float(w & 0xffff0000u); }

namespace pg8 {
constexpr int BM = 256, BK = 64, HALF = 128, HTB = HALF * BK * 2, STAGE_BYTES = 8 * HTB, NXCD = 8, WGM = 8;
__host__ __device__ __forceinline__ int lds_byte(int r, int c) { const int st = (r >> 4) * 2 + (c >> 5), rr = r & 15, cc = c & 31, ob = rr * 64 + cc * 2; return st * 1024 + (ob ^ (((ob >> 9) & 1) << 5)); }
__host__ __device__ __forceinline__ void stage_rc(int b, int& R, int& C) { const int st = b / 1024, sb = b % 1024, swz = sb ^ (((sb >> 9) & 1) << 5); R = (st >> 1) * 16 + swz / 64; C = (st & 1) * 32 + (swz % 64) / 2; }
__host__ __device__ __forceinline__ int perm32(int rho) { const int n = rho >> 4, i = rho & 15; return 8 * (i >> 2) + 4 * n + (i & 3); }
struct Unit { int pm, pn; };
struct Gemm { const bf16_t* A; const bf16_t* Bt; int M, N, K, lda; };
struct StaticOrder {
    int nM, nN, nwg, G, c, pm_off;
    __device__ void init(int M, int N, int G_, int c_, int pm_off_ = 0) { nM = M / BM; nN = N / BM; nwg = nM * nN; G = G_; c = c_; pm_off = pm_off_; }
    __device__ bool next(int i, Unit& u) const {
        const long L = (long)i * G + c; if (L >= nwg) return false;
        int wgid = (int)L; { const int q = nwg / NXCD, r = nwg % NXCD, xcd = wgid % NXCD, off = wgid / NXCD; wgid = (xcd < r ? xcd * (q + 1) : r * (q + 1) + (xcd - r) * q) + off; }
        const int nig = WGM * nN, gid = wgid / nig, fm = gid * WGM, gsz = (nM - fm) < WGM ? (nM - fm) : WGM;
        u.pm = pm_off + fm + ((wgid % nig) % gsz); u.pn = (wgid % nig) / gsz; return true;
    }
};
template <class Epi>
__device__ __forceinline__ void gemm_phase(LAS unsigned char* lds, const Gemm g, const StaticOrder& S, const Epi& E) {
    int tid_ = threadIdx.x; asm volatile("" : "+v"(tid_));
    const int tid = tid_, wid = __builtin_amdgcn_readfirstlane(tid >> 6), lane = tid & 63, wr = wid >> 2, wc = wid & 3, fr = lane & 15, fq = lane >> 4;
    const int K = g.K, nt = K / BK, lda = g.lda;
    unsigned voffA[2], voffB[2];
#pragma unroll
    for (int i = 0; i < 2; ++i) { int R, C; stage_rc(tid * 16 + i * 8192, R, C); const int Rb = (R & ~31) + perm32(R & 31);
        const int Ra = (R & ~63) + 4 * (R & 15) + ((R >> 4) & 3);
        voffA[i] = (unsigned)(Ra * lda + C) * 2u; voffB[i] = (unsigned)(Rb * K + C) * 2u; }
    const size_t kstep = (size_t)(BK * 2);
    const size_t hstepA = (size_t)HALF * lda * 2, hstepB = (size_t)HALF * K * 2;
    const size_t tstepA = 2 * hstepA, tstepB = 2 * hstepB;
    const unsigned ldsw = (unsigned)wid * 1024u;
    const int aoff = lds_byte(wr * 64 + fr, fq * 8), boff = lds_byte(wc * 32 + fr, fq * 8);
#define PG8_SA(b, h) (((b) * 2 + (h)) * HTB)
#define PG8_SB(b, h) ((4 + (b) * 2 + (h)) * HTB)
#define PG8_STAGE(bufoff, gbase, voff) do { _Pragma("unroll") for (int _i = 0; _i < 2; ++_i) \
        __builtin_amdgcn_global_load_lds((const unsigned*)((const char*)(gbase) + (voff)[_i]), (LAS unsigned*)(lds + (bufoff) + ldsw + _i * 8192), 16, 0, 0); } while (0)
#define PG8_LDA(dst, b, h) do { _Pragma("unroll") for (int m = 0; m < 4; ++m) _Pragma("unroll") for (int k = 0; k < 2; ++k) dst[m][k] = *(const LAS bf16x8*)(lds + PG8_SA(b, h) + aoff + m * 2048 + k * 1024); } while (0)
#define PG8_LDB(dst, b, h) do { _Pragma("unroll") for (int n = 0; n < 2; ++n) _Pragma("unroll") for (int k = 0; k < 2; ++k) dst[n][k] = *(const LAS bf16x8*)(lds + PG8_SB(b, h) + boff + n * 2048 + k * 1024); } while (0)
#define PG8_MMA(ai, bj, At, Bt) do { __builtin_amdgcn_s_setprio(1); _Pragma("unroll") for (int m = 0; m < 4; ++m) _Pragma("unroll") for (int n = 0; n < 2; ++n) _Pragma("unroll") for (int k = 0; k < 2; ++k) \
        acc[ai][bj][m][n] = __builtin_amdgcn_mfma_f32_16x16x32_bf16(Bt[n][k], At[m][k], acc[ai][bj][m][n], 0, 0, 0); __builtin_amdgcn_s_setprio(0); } while (0)
#define PG8_WAIT_V(n) asm volatile("s_waitcnt vmcnt(" #n ")" ::: "memory")
#define PG8_WAIT_L(n) asm volatile("s_waitcnt lgkmcnt(" #n ")" ::: "memory")
#define PG8_BAR __builtin_amdgcn_s_barrier()
#define PG8_SCHED __builtin_amdgcn_sched_barrier(0)
    Unit cur, nxt; int ui = 0;
    if (!S.next(0, cur)) return;
    f32x4 acc[2][2][4][2];
#pragma unroll
    for (int a = 0; a < 2; ++a)
#pragma unroll
        for (int b = 0; b < 2; ++b)
#pragma unroll
            for (int m = 0; m < 4; ++m)
#pragma unroll
                for (int n = 0; n < 2; ++n) acc[a][b][m][n] = (f32x4){0.f, 0.f, 0.f, 0.f};
    bf16x8 At[4][2], B0[2][2], B1[2][2];
    const char* cA = (const char*)g.A + (size_t)cur.pm * tstepA; const char* cB = (const char*)g.Bt + (size_t)cur.pn * tstepB;
    PG8_STAGE(PG8_SB(0, 0), cB, voffB); PG8_STAGE(PG8_SB(0, 1), cB + hstepB, voffB); PG8_STAGE(PG8_SA(0, 0), cA, voffA); PG8_STAGE(PG8_SA(0, 1), cA + hstepA, voffA);
    if (wr == 1) PG8_BAR;
    PG8_WAIT_V(2); PG8_BAR;
    PG8_STAGE(PG8_SB(1, 0), cB + kstep, voffB); PG8_STAGE(PG8_SA(1, 0), cA + kstep, voffA); PG8_STAGE(PG8_SB(1, 1), cB + hstepB + kstep, voffB);
    PG8_WAIT_V(6); PG8_BAR;
    for (;;) {
        const bool has_next = S.next(ui + 1, nxt);
        const char* nA = has_next ? (const char*)g.A + (size_t)nxt.pm * tstepA : cA; const char* nB = has_next ? (const char*)g.Bt + (size_t)nxt.pn * tstepB : cB;
        for (int t = 0; t < nt; t += 2) {
            const bool last = (t == nt - 2);
            if constexpr (Epi::PREFETCH) { if (t == 2) E.prefetch(cur, wr, wc, lane); }
            const char* a1 = cA + (size_t)(t + 1) * kstep;
            const char* a2 = last ? nA : cA + (size_t)(t + 2) * kstep; const char* b2 = last ? nB : cB + (size_t)(t + 2) * kstep;
            const char* a3 = a2 + kstep; const char* b3 = b2 + kstep;
            PG8_LDB(B0, 0, 0); PG8_LDB(B1, 0, 1); PG8_SCHED; PG8_LDA(At, 0, 0); PG8_STAGE(PG8_SA(1, 1), a1 + hstepA, voffA);
            PG8_WAIT_V(8); PG8_WAIT_L(0); PG8_BAR; PG8_MMA(0, 0, At, B0); PG8_MMA(0, 1, At, B1); PG8_BAR; PG8_SCHED;
            PG8_LDA(At, 0, 1); PG8_STAGE(PG8_SB(0, 0), b2, voffB); PG8_STAGE(PG8_SB(0, 1), b2 + hstepB, voffB); PG8_STAGE(PG8_SA(0, 0), a2, voffA);
            PG8_WAIT_V(8); PG8_WAIT_L(0); PG8_BAR; PG8_MMA(1, 0, At, B0); PG8_MMA(1, 1, At, B1); PG8_BAR; PG8_SCHED;
            PG8_LDB(B0, 1, 0); PG8_LDB(B1, 1, 1); PG8_SCHED; PG8_LDA(At, 1, 0); PG8_STAGE(PG8_SA(0, 1), a2 + hstepA, voffA);
            PG8_WAIT_V(8); PG8_WAIT_L(0); PG8_BAR; PG8_MMA(0, 0, At, B0); PG8_MMA(0, 1, At, B1); PG8_BAR; PG8_SCHED;
            PG8_LDA(At, 1, 1); PG8_STAGE(PG8_SB(1, 0), b3, voffB); PG8_STAGE(PG8_SB(1, 1), b3 + hstepB, voffB); PG8_STAGE(PG8_SA(1, 0), a3, voffA);
            PG8_WAIT_V(8); PG8_WAIT_L(0); PG8_BAR; PG8_MMA(1, 0, At, B0); PG8_MMA(1, 1, At, B1); PG8_BAR; PG8_SCHED;
        }
        if (wr == 0) PG8_BAR;
        E(acc, cur, wr, wc, fr, fq);
        if (!has_next) break;
#pragma unroll
        for (int a = 0; a < 2; ++a)
#pragma unroll
            for (int b = 0; b < 2; ++b)
#pragma unroll
                for (int m = 0; m < 4; ++m)
#pragma unroll
                    for (int n = 0; n < 2; ++n) acc[a][b][m][n] = (f32x4){0.f, 0.f, 0.f, 0.f};
        cur = nxt; cA = nA; cB = nB; ++ui;
        if (wr == 1) PG8_BAR;
    }
    PG8_WAIT_V(0);
    PG8_BAR;
#undef PG8_SA
#undef PG8_SB
#undef PG8_STAGE
#undef PG8_LDA
#undef PG8_LDB
#undef PG8_MMA
#undef PG8_WAIT_V
#undef PG8_WAIT_L
#undef PG8_BAR
#undef PG8_SCHED
}
}
using pg8::Unit;

__device__ __forceinline__ void rope_apply(f32x4& v0, f32x4& v1, int kind, int row, int wc, int fq, const float* tabM, const float* tabS) {
    const int t = row & 2047, gr = t >> 6, gc = t & 63;
    const float* tb; float sgn; f32x4 p0, p1;
    if (kind == 1) {
        const int pos = (fq < 2) ? gr : gc; tb = tabM + pos * 16; sgn = (fq & 1) ? 1.f : -1.f;
#pragma unroll
        for (int e = 0; e < 4; ++e) { p0[e] = __shfl_xor(v0[e], 16); p1[e] = __shfl_xor(v1[e], 16); }
    } else {
        const int pos = (wc & 1) ? gc : gr; tb = tabS + pos * 32 + (fq & 1) * 16; sgn = (fq & 2) ? 1.f : -1.f;
#pragma unroll
        for (int e = 0; e < 4; ++e) { p0[e] = __shfl_xor(v0[e], 32); p1[e] = __shfl_xor(v1[e], 32); }
    }
    const f32x4 c0 = *(const f32x4*)(tb), c1 = *(const f32x4*)(tb + 4), c2 = *(const f32x4*)(tb + 8), c3 = *(const f32x4*)(tb + 12);
    v0[0] = v0[0] * c0[0] + sgn * p0[0] * c0[1]; v0[1] = v0[1] * c0[2] + sgn * p0[1] * c0[3];
    v0[2] = v0[2] * c1[0] + sgn * p0[2] * c1[1]; v0[3] = v0[3] * c1[2] + sgn * p0[3] * c1[3];
    v1[0] = v1[0] * c2[0] + sgn * p1[0] * c2[1]; v1[1] = v1[1] * c2[2] + sgn * p1[1] * c2[3];
    v1[2] = v1[2] * c3[0] + sgn * p1[2] * c3[1]; v1[3] = v1[3] * c3[2] + sgn * p1[3] * c3[3];
}
__device__ __forceinline__ void store_bf16x8(bf16_t* p, f32x4 v0, f32x4 v1) {
    u32x4 w; w.x = cvt_pk_bf16(v0[0], v0[1]); w.y = cvt_pk_bf16(v0[2], v0[3]); w.z = cvt_pk_bf16(v1[0], v1[1]); w.w = cvt_pk_bf16(v1[2], v1[3]);
    *(u32x4*)p = w;
}

struct EpiZ { static constexpr bool PREFETCH = false;
    bf16_t* Z; int ldz; int odd; const float* tabM; const float* tabS; float* ssq;
    __device__ __forceinline__ void operator()(const f32x4 (&acc)[2][2][4][2], const Unit& u, int wr_in, int wc_in, int fr_in, int fq_in) const {
        int fr = fr_in, fq = fq_in, wr = wr_in, wc = wc_in; asm volatile("" : "+v"(fr), "+v"(fq), "+s"(wr), "+s"(wc));
        const bool lat = u.pm < 128;
#pragma unroll
        for (int bj = 0; bj < 2; ++bj) {
            const int g32 = u.pn * 8 + bj * 4 + wc;
            if (!odd && g32 >= 48 && g32 < 68) {
#pragma unroll
                for (int ai = 0; ai < 2; ++ai)
#pragma unroll
                    for (int m = 0; m < 4; ++m) {
                        const f32x4 a = acc[ai][bj][m][0], b = acc[ai][bj][m][1];
                        float ss = (a[0] * a[0] + a[1] * a[1]) + (a[2] * a[2] + a[3] * a[3]) + (b[0] * b[0] + b[1] * b[1]) + (b[2] * b[2] + b[3] * b[3]);
                        ss += __shfl_xor(ss, 16); ss += __shfl_xor(ss, 32);
                        if (fq == 0) ssq[(size_t)(u.pm * 256 + ai * 128 + wr * 64 + 4 * fr + m) * 20 + (g32 - 48)] = ss;
                    }
            }
            int rope = 0; float sc = 1.f;
            if (!odd) { if (g32 < 16) sc = QS64; if (g32 == 68 && lat) rope = 1; }
            else { if (g32 < 32) sc = QS64; if (g32 < 36 && lat) rope = 2; }
            const int col0 = g32 * 32 + 8 * fq;
#pragma unroll
            for (int ai = 0; ai < 2; ++ai)
#pragma unroll
                for (int m = 0; m < 4; ++m) {
                    const int row = u.pm * 256 + ai * 128 + wr * 64 + 4 * fr + m;
                    f32x4 v0 = acc[ai][bj][m][0], v1 = acc[ai][bj][m][1];
                    if (rope) rope_apply(v0, v1, rope, row, wc, fq, tabM, tabS);
                    v0 = v0 * sc; v1 = v1 * sc;
                    store_bf16x8(Z + (size_t)row * ldz + col0, v0, v1);
                }
        }
    }
};
struct EpiQK { static constexpr bool PREFETCH = false;
    bf16_t* O; int ldo; const float* ssq; int nslot; float invn; int isq; const float* tabM;
    __device__ __forceinline__ void operator()(const f32x4 (&acc)[2][2][4][2], const Unit& u, int wr_in, int wc_in, int fr_in, int fq_in) const {
        int fr = fr_in, fq = fq_in, wr = wr_in, wc = wc_in; asm volatile("" : "+v"(fr), "+v"(fq), "+s"(wr), "+s"(wc));
        const bool lat = u.pm < 128;
        const float sc = isq ? QS96 : 1.f;
#pragma unroll
        for (int ai = 0; ai < 2; ++ai)
#pragma unroll
            for (int m = 0; m < 4; ++m) {
                const int row = u.pm * 256 + ai * 128 + wr * 64 + 4 * fr + m;
                const float* sp = ssq + (size_t)row * 20;
                const f32x4 p0 = *(const f32x4*)(sp), p1 = *(const f32x4*)(sp + 4);
                float ss = (p0[0] + p0[1]) + (p0[2] + p0[3]) + (p1[0] + p1[1]) + (p1[2] + p1[3]);
                if (nslot == 12) { const f32x4 p2 = *(const f32x4*)(sp + 8); ss += (p2[0] + p2[1]) + (p2[2] + p2[3]); }
                const float rs = sc / sqrtf(ss * invn + RMS_EPS);
#pragma unroll
                for (int bj = 0; bj < 2; ++bj) {
                    const int g32 = u.pn * 8 + bj * 4 + wc;
                    const int rope = (isq && lat && (g32 % 3 == 2)) ? 1 : 0;
                    f32x4 v0 = acc[ai][bj][m][0] * rs, v1 = acc[ai][bj][m][1] * rs;
                    if (rope) rope_apply(v0, v1, 1, row, wc, fq, tabM, tabM);
                    store_bf16x8(O + (size_t)row * ldo + g32 * 32 + 8 * fq, v0, v1);
                }
            }
    }
};
struct EpiRes { static constexpr bool PREFETCH = false;
    const float* srcL; const float* srcC; float* dstL; float* dstC; const float* gate; const float* bias; const float* stat;
    __device__ __forceinline__ void operator()(const f32x4 (&acc)[2][2][4][2], const Unit& u, int wr_in, int wc_in, int fr_in, int fq_in) const {
        int fr = fr_in, fq = fq_in, wr = wr_in, wc = wc_in; asm volatile("" : "+v"(fr), "+v"(fq), "+s"(wr), "+s"(wc));
        const bool lat = u.pm < 128;
        const int b = lat ? (u.pm >> 3) : 16;
        const float* gp = gate + (size_t)b * 6144;
        const float* src = lat ? srcL : srcC; float* dst = lat ? dstL : dstC;
        const int rbase = (lat ? u.pm : (u.pm - 128)) * 256 + wr * 64 + 4 * fr;
        const int colw = u.pn * 256 + wc * 32 + 8 * fq;
#pragma unroll
        for (int ai = 0; ai < 2; ++ai) {
            float sa[4], sb[4];
#pragma unroll
            for (int m = 0; m < 4; ++m) { sa[m] = ALPHA; sb[m] = 0.f;
                if (stat) { const float2 st = *(const float2*)(stat + 2 * (size_t)(u.pm * 256 + wr * 64 + 4 * fr + ai * 128 + m)); sa[m] = ALPHA * st.y; sb[m] = -sa[m] * st.x; } }
#pragma unroll
            for (int bj = 0; bj < 2; ++bj) {
                const int col0 = colw + bj * 128;
                f32x4 x[4][2];
#pragma unroll
                for (int m = 0; m < 4; ++m) { const float* p = src + (size_t)(rbase + ai * 128 + m) * DM + col0; x[m][0] = *(const f32x4*)(p); x[m][1] = *(const f32x4*)(p + 4); }
                const f32x4 g0 = *(const f32x4*)(gp + col0), g1 = *(const f32x4*)(gp + col0 + 4);
                f32x4 b0 = (f32x4){0.f, 0.f, 0.f, 0.f}, b1 = b0;
                if (bias) { b0 = *(const f32x4*)(bias + col0); b1 = *(const f32x4*)(bias + col0 + 4); }
#pragma unroll
                for (int m = 0; m < 4; ++m) {
                    float* q = dst + (size_t)(rbase + ai * 128 + m) * DM + col0;
                    const f32x4 r0 = x[m][0] * sa[m] + sb[m] + g0 * (acc[ai][bj][m][0] + b0), r1 = x[m][1] * sa[m] + sb[m] + g1 * (acc[ai][bj][m][1] + b1);
                    *(f32x4*)(q) = r0; *(f32x4*)(q + 4) = r1;
                }
                __builtin_amdgcn_sched_barrier(0);
            }
        }
    }
};
__device__ __forceinline__ float dpp_shr1(float v) { return __builtin_bit_cast(float, __builtin_amdgcn_update_dpp(0, __builtin_bit_cast(int, v), 0x111, 0xf, 0xf, true)); }
__device__ __forceinline__ float dpp_shl1(float v) { return __builtin_bit_cast(float, __builtin_amdgcn_update_dpp(0, __builtin_bit_cast(int, v), 0x101, 0xf, 0xf, true)); }
struct EpiUp { static constexpr bool PREFETCH = true;
    bf16_t* G; float* halo; const float* b_up; const float* conv_w; const float* conv_b; LAS float* pl;
    __device__ __forceinline__ void prefetch(const Unit& u, int wr, int wc, int lane_in) const {
        int lane = lane_in; asm volatile("" : "+v"(lane));
        const int cw0 = u.pn * 128 + wc * 32;
        LAS float* P = pl + (wr * 4 + wc) * 320;
#pragma unroll
        for (int k = 0; k < 5; ++k) { const int idx = lane + 64 * k, p = idx >> 5, c = idx & 31; const int col = cw0 + c + (p >= 5 ? FFH : 0); const int pp = p >= 5 ? p - 5 : p;
            const float* src = (pp == 0) ? b_up + col : (pp == 4) ? conv_b + col : conv_w + (size_t)(pp - 1) * FF2 + col;
            __builtin_amdgcn_global_load_lds((const unsigned*)src, (LAS unsigned*)(P + 64 * k), 4, 0, 0); }
    }
    __device__ __forceinline__ void operator()(const f32x4 (&acc)[2][2][4][2], const Unit& u, int wr_in, int wc_in, int fr_in, int fq_in) const {
        typedef float f32x2 __attribute__((ext_vector_type(2)));
        int fr = fr_in, fq = fq_in, wr = wr_in, wc = wc_in; asm volatile("" : "+v"(fr), "+v"(fq), "+s"(wr), "+s"(wc));
        const int lane = fq * 16 + fr;
        const int cw0 = u.pn * 128 + wc * 32;
        const int ca0 = cw0 + 8 * fq;
        const int tcol0 = u.pn * 256 + wc * 32 + 8 * fq;
        LAS float* P = pl + (wr * 4 + wc) * 320;
        (void)lane;
#pragma unroll
        for (int ai = 0; ai < 2; ++ai) {
            if (fr == 0 || fr == 15) {
                const int g64 = u.pm * 4 + ai * 2 + wr;
                float* hp = halo + ((size_t)(g64 * 4 + (fr ? 2 : 0))) * FF2 + tcol0;
#pragma unroll
                for (int n = 0; n < 2; ++n) {
                    const f32x4 bua = *(const LAS f32x4*)(P + 8 * fq + 4 * n), bug = *(const LAS f32x4*)(P + 160 + 8 * fq + 4 * n);
                    const f32x4 a0 = fr ? acc[ai][0][2][n] : acc[ai][0][0][n], a1 = fr ? acc[ai][0][3][n] : acc[ai][0][1][n];
                    const f32x4 g0 = fr ? acc[ai][1][2][n] : acc[ai][1][0][n], g1 = fr ? acc[ai][1][3][n] : acc[ai][1][1][n];
                    *(f32x4*)(hp + 4 * n) = a0 + bua; *(f32x4*)(hp + 128 + 4 * n) = g0 + bug;
                    *(f32x4*)(hp + FF2 + 4 * n) = a1 + bua; *(f32x4*)(hp + FF2 + 128 + 4 * n) = g1 + bug;
                }
            }
            u32x4 pk[4];
#pragma unroll
            for (int n = 0; n < 2; ++n)
#pragma unroll
                for (int ep = 0; ep < 2; ++ep) {
                    const int e0 = 2 * ep; const LAS float* pc = P + 8 * fq + 4 * n + e0;
                    const f32x2 bua = *(const LAS f32x2*)(pc), w0a = *(const LAS f32x2*)(pc + 32), w1a = *(const LAS f32x2*)(pc + 64), w2a = *(const LAS f32x2*)(pc + 96), cba = *(const LAS f32x2*)(pc + 128);
                    const f32x2 bug = *(const LAS f32x2*)(pc + 160), w0g = *(const LAS f32x2*)(pc + 192), w1g = *(const LAS f32x2*)(pc + 224), w2g = *(const LAS f32x2*)(pc + 256), cbg = *(const LAS f32x2*)(pc + 288);
                    f32x2 av[4];
                    {
                        f32x2 x[4], pv, nv;
#pragma unroll
                        for (int m = 0; m < 4; ++m) { x[m].x = acc[ai][0][m][n][e0]; x[m].y = acc[ai][0][m][n][e0 + 1]; x[m] = x[m] + bua; }
                        pv.x = dpp_shr1(x[3].x); pv.y = dpp_shr1(x[3].y); nv.x = dpp_shl1(x[0].x); nv.y = dpp_shl1(x[0].y);
                        av[0] = w0a * pv + w1a * x[0] + w2a * x[1] + cba;
                        av[1] = w0a * x[0] + w1a * x[1] + w2a * x[2] + cba;
                        av[2] = w0a * x[1] + w1a * x[2] + w2a * x[3] + cba;
                        av[3] = w0a * x[2] + w1a * x[3] + w2a * nv + cba;
                    }
                    {
                        f32x2 x[4], pv, nv, gv[4];
#pragma unroll
                        for (int m = 0; m < 4; ++m) { x[m].x = acc[ai][1][m][n][e0]; x[m].y = acc[ai][1][m][n][e0 + 1]; x[m] = x[m] + bug; }
                        pv.x = dpp_shr1(x[3].x); pv.y = dpp_shr1(x[3].y); nv.x = dpp_shl1(x[0].x); nv.y = dpp_shl1(x[0].y);
                        gv[0] = w0g * pv + w1g * x[0] + w2g * x[1] + cbg;
                        gv[1] = w0g * x[0] + w1g * x[1] + w2g * x[2] + cbg;
                        gv[2] = w0g * x[1] + w1g * x[2] + w2g * x[3] + cbg;
                        gv[3] = w0g * x[2] + w1g * x[3] + w2g * nv + cbg;
#pragma unroll
                        for (int m = 0; m < 4; ++m) {
                            const f32x2 t = gv[m] * (-LOG2E);
                            f32x2 sg; sg.x = __builtin_amdgcn_rcpf(1.0f + __builtin_amdgcn_exp2f(t.x)); sg.y = __builtin_amdgcn_rcpf(1.0f + __builtin_amdgcn_exp2f(t.y));
                            const f32x2 ov = av[m] * gv[m] * sg;
                            pk[m][2 * n + ep] = cvt_pk_bf16(ov.x, ov.y); }
                    }
                    __builtin_amdgcn_sched_barrier(0);
                }
            bf16_t* gp = G + (size_t)(u.pm * 256 + ai * 128 + wr * 64 + 4 * fr) * FFH + ca0;
            if (fr != 0) *(u32x4*)(gp) = pk[0];
            *(u32x4*)(gp + FFH) = pk[1];
            *(u32x4*)(gp + 2 * FFH) = pk[2];
            if (fr != 15) *(u32x4*)(gp + 3 * FFH) = pk[3];
        }
    }
};

struct AttnDesc {
    const bf16_t* q; int ldq;
    bf16_t* o; int ldo;
    const bf16_t* k; int ldk;
    const bf16_t* kr; int ldkr;
    const bf16_t* v; int ldv;
    int nloc, loc_row0, ctx_row0;
    int mode;
    int a0, a1, a2;
    float sink;
};
constexpr int ATT_KBUF = 64 * 208, ATT_VOFF = 2 * ATT_KBUF, ATT_RPB = ATT_VOFF + 2 * 8192;
constexpr int ATT2_KSTG = 2 * ATT_KBUF, ATT2_VOFF = 2 * ATT2_KSTG, ATT2_VSTG = 2 * 8192;

__device__ __forceinline__ void attn_unit_mla(LAS unsigned char* lds, const AttnDesc& A, int tid_in, int wid, int lane_in) {
    constexpr int KSTR = (96 + 8) * 2, NS = 6;
    int tid = tid_in; asm volatile("" : "+v"(tid));
    const int lane = tid & 63; (void)lane_in;
    const int r32 = lane & 31, h = lane >> 5;
    const int nt = A.nloc + 4, nstg = nt >> 1;
    bf16x8 qf[NS];
#pragma unroll
    for (int s = 0; s < NS; ++s) qf[s] = *(const bf16x8*)(A.q + (size_t)r32 * A.ldq + 16 * s + 8 * h);
    f32x16 o0, o1;
#pragma unroll
    for (int r = 0; r < 16; ++r) { o0[r] = 0.f; o1[r] = 0.f; }
    float mrun = -1e30f, lrun = 0.f;
    const int skey = tid >> 3, sch = tid & 7;
    u32x4 ka, va, kra = (u32x4){0u, 0u, 0u, 0u}, kb_, vb_, krb = (u32x4){0u, 0u, 0u, 0u};
#define MLA_LOAD(KR, VR, KRR, tt) do { const int t1_ = (tt); const int row0_ = (t1_ < A.nloc) ? A.loc_row0 + 64 * t1_ : A.ctx_row0 + 64 * (t1_ - A.nloc); \
        KR = *(const u32x4*)(A.k + (size_t)(row0_ + skey) * A.ldk + 8 * sch); VR = *(const u32x4*)(A.v + (size_t)(row0_ + skey) * A.ldv + 8 * sch); \
        if (tid < 256) KRR = *(const u32x4*)(A.kr + (size_t)(row0_ + (tid >> 2)) * A.ldkr + 8 * (tid & 3)); } while (0)
#define MLA_STORE(KR, VR, KRR, kbp, vbp) do { *(LAS u32x4*)((kbp) + skey * KSTR + sch * 16) = KR; \
        if (tid < 256) *(LAS u32x4*)((kbp) + (tid >> 2) * KSTR + 128 + (tid & 3) * 16) = KRR; \
        *(LAS u32x4*)((vbp) + (sch >> 2) * 4096 + skey * 64 + (sch & 3) * 16) = VR; } while (0)
    MLA_LOAD(ka, va, kra, 0); MLA_LOAD(kb_, vb_, krb, 1);
    const int vtr_off = ((lane & 15) >> 2) * 64 + (16 * ((lane >> 4) & 1) + 4 * (lane & 3)) * 2 + 4 * h * 64;
#define MLA_VRD0(VA, VC, vbp) do { const LAS unsigned char* vp = (vbp) + vtr_off; \
            const s16x4 a0 = __builtin_bit_cast(s16x4, __builtin_amdgcn_ds_read_tr16_b64_v4i16((LAS s16x4*)(vp))); \
            const s16x4 a1 = __builtin_bit_cast(s16x4, __builtin_amdgcn_ds_read_tr16_b64_v4i16((LAS s16x4*)(vp + 8 * 64))); \
            const s16x4 c0 = __builtin_bit_cast(s16x4, __builtin_amdgcn_ds_read_tr16_b64_v4i16((LAS s16x4*)(vp + 4096))); \
            const s16x4 c1 = __builtin_bit_cast(s16x4, __builtin_amdgcn_ds_read_tr16_b64_v4i16((LAS s16x4*)(vp + 4096 + 8 * 64))); \
            VA = (bf16x8){a0[0], a0[1], a0[2], a0[3], a1[0], a1[1], a1[2], a1[3]}; VC = (bf16x8){c0[0], c0[1], c0[2], c0[3], c1[0], c1[1], c1[2], c1[3]}; } while (0)
    for (int st = 0; st < nstg; ++st) {
        LAS unsigned char* kbuf = lds + (st & 1) * ATT2_KSTG;
        LAS unsigned char* vbuf = lds + ATT2_VOFF + (st & 1) * ATT2_VSTG;
        MLA_STORE(ka, va, kra, kbuf, vbuf); MLA_STORE(kb_, vb_, krb, kbuf + ATT_KBUF, vbuf + 8192);
        __syncthreads();
        if (st + 1 < nstg) { MLA_LOAD(ka, va, kra, 2 * st + 2); MLA_LOAD(kb_, vb_, krb, 2 * st + 3); }
        f32x16 s0, s1, s2, s3;
#pragma unroll
        for (int r = 0; r < 16; ++r) { s0[r] = 0.f; s1[r] = 0.f; s2[r] = 0.f; s3[r] = 0.f; }
        __builtin_amdgcn_s_setprio(1);
        bf16x8 kf[2][4];
#define MLA_KRD(SET, st_) do { const int co_ = (16 * (st_) + 8 * h) * 2; \
            kf[SET][0] = *(const LAS bf16x8*)(kbuf + r32 * KSTR + co_); kf[SET][1] = *(const LAS bf16x8*)(kbuf + (32 + r32) * KSTR + co_); \
            kf[SET][2] = *(const LAS bf16x8*)(kbuf + ATT_KBUF + r32 * KSTR + co_); kf[SET][3] = *(const LAS bf16x8*)(kbuf + ATT_KBUF + (32 + r32) * KSTR + co_); } while (0)
        MLA_KRD(0, 0);
        __builtin_amdgcn_sched_group_barrier(0x100, 4, 0);
#pragma unroll
        for (int s = 0; s < NS; ++s) {
            if (s + 1 < NS) { MLA_KRD((s + 1) & 1, s + 1); __builtin_amdgcn_sched_group_barrier(0x100, 4, 0); }
            s0 = __builtin_amdgcn_mfma_f32_32x32x16_bf16(kf[s & 1][0], qf[s], s0, 0, 0, 0);
            s1 = __builtin_amdgcn_mfma_f32_32x32x16_bf16(kf[s & 1][1], qf[s], s1, 0, 0, 0);
            s2 = __builtin_amdgcn_mfma_f32_32x32x16_bf16(kf[s & 1][2], qf[s], s2, 0, 0, 0);
            s3 = __builtin_amdgcn_mfma_f32_32x32x16_bf16(kf[s & 1][3], qf[s], s3, 0, 0, 0);
            __builtin_amdgcn_sched_group_barrier(0x008, 4, 0);
        }
#undef MLA_KRD
        __builtin_amdgcn_s_setprio(0);
        bf16x8 va0, vc0;
        MLA_VRD0(va0, vc0, vbuf);
        float m0 = fmaxf(fmaxf(s0[0], s1[0]), fmaxf(s2[0], s3[0]));
#pragma unroll
        for (int r = 1; r < 16; ++r) { m0 = fmaxf(fmaxf(m0, s0[r]), s1[r]); m0 = fmaxf(fmaxf(m0, s2[r]), s3[r]); }
        float mx = fmaxf(m0, __shfl_xor(m0, 32));
        if (__builtin_amdgcn_ballot_w64(mx > mrun + 8.0f) != 0ull) {
            const float mnew = fmaxf(mrun, mx);
            const float alpha = __builtin_amdgcn_exp2f(mrun - mnew);
            mrun = mnew; lrun *= alpha;
#pragma unroll
            for (int r = 0; r < 16; ++r) { o0[r] *= alpha; o1[r] *= alpha; }
        }
        float ra = 0.f, rb = 0.f;
#pragma unroll
        for (int r = 0; r < 16; ++r) { s0[r] = __builtin_amdgcn_exp2f(s0[r] - mrun); s1[r] = __builtin_amdgcn_exp2f(s1[r] - mrun); s2[r] = __builtin_amdgcn_exp2f(s2[r] - mrun); s3[r] = __builtin_amdgcn_exp2f(s3[r] - mrun);
            ra += s0[r] + s1[r]; rb += s2[r] + s3[r]; }
        lrun += ra + rb;
#define MLA_PACK(S, q) __builtin_bit_cast(bf16x8, (u32x4){cvt_pk_bf16_m(S[8 * (q) + 0], S[8 * (q) + 1]), cvt_pk_bf16_m(S[8 * (q) + 2], S[8 * (q) + 3]), cvt_pk_bf16_m(S[8 * (q) + 4], S[8 * (q) + 5]), cvt_pk_bf16_m(S[8 * (q) + 6], S[8 * (q) + 7])})
#define MLA_PV(PF, vbp, ks) do { const LAS unsigned char* vp = (vbp) + vtr_off + (ks) * 16 * 64; \
            const s16x4 a0 = __builtin_bit_cast(s16x4, __builtin_amdgcn_ds_read_tr16_b64_v4i16((LAS s16x4*)(vp))); \
            const s16x4 a1 = __builtin_bit_cast(s16x4, __builtin_amdgcn_ds_read_tr16_b64_v4i16((LAS s16x4*)(vp + 8 * 64))); \
            const s16x4 c0 = __builtin_bit_cast(s16x4, __builtin_amdgcn_ds_read_tr16_b64_v4i16((LAS s16x4*)(vp + 4096))); \
            const s16x4 c1 = __builtin_bit_cast(s16x4, __builtin_amdgcn_ds_read_tr16_b64_v4i16((LAS s16x4*)(vp + 4096 + 8 * 64))); \
            const bf16x8 va_ = (bf16x8){a0[0], a0[1], a0[2], a0[3], a1[0], a1[1], a1[2], a1[3]}; \
            const bf16x8 vc_ = (bf16x8){c0[0], c0[1], c0[2], c0[3], c1[0], c1[1], c1[2], c1[3]}; \
            o0 = __builtin_amdgcn_mfma_f32_32x32x16_bf16(va_, PF, o0, 0, 0, 0); o1 = __builtin_amdgcn_mfma_f32_32x32x16_bf16(vc_, PF, o1, 0, 0, 0); } while (0)
        __builtin_amdgcn_s_setprio(1);
#define MLA_VRD(VA, VC, vbp, ks) do { const LAS unsigned char* vp = (vbp) + vtr_off + (ks) * 16 * 64; \
            const s16x4 a0 = __builtin_bit_cast(s16x4, __builtin_amdgcn_ds_read_tr16_b64_v4i16((LAS s16x4*)(vp))); \
            const s16x4 a1 = __builtin_bit_cast(s16x4, __builtin_amdgcn_ds_read_tr16_b64_v4i16((LAS s16x4*)(vp + 8 * 64))); \
            const s16x4 c0 = __builtin_bit_cast(s16x4, __builtin_amdgcn_ds_read_tr16_b64_v4i16((LAS s16x4*)(vp + 4096))); \
            const s16x4 c1 = __builtin_bit_cast(s16x4, __builtin_amdgcn_ds_read_tr16_b64_v4i16((LAS s16x4*)(vp + 4096 + 8 * 64))); \
            VA = (bf16x8){a0[0], a0[1], a0[2], a0[3], a1[0], a1[1], a1[2], a1[3]}; VC = (bf16x8){c0[0], c0[1], c0[2], c0[3], c1[0], c1[1], c1[2], c1[3]}; } while (0)
#define MLA_MM(PF, VA, VC) do { o0 = __builtin_amdgcn_mfma_f32_32x32x16_bf16(VA, PF, o0, 0, 0, 0); o1 = __builtin_amdgcn_mfma_f32_32x32x16_bf16(VC, PF, o1, 0, 0, 0); } while (0)
        { bf16x8 va1, vc1;
          { const bf16x8 p = MLA_PACK(s0, 0); MLA_VRD(va1, vc1, vbuf, 1); MLA_MM(p, va0, vc0); }
          { const bf16x8 p = MLA_PACK(s0, 1); MLA_VRD(va0, vc0, vbuf, 2); MLA_MM(p, va1, vc1); }
          { const bf16x8 p = MLA_PACK(s1, 0); MLA_VRD(va1, vc1, vbuf, 3); MLA_MM(p, va0, vc0); }
          { const bf16x8 p = MLA_PACK(s1, 1); MLA_VRD(va0, vc0, vbuf + 8192, 0); MLA_MM(p, va1, vc1); }
          { const bf16x8 p = MLA_PACK(s2, 0); MLA_VRD(va1, vc1, vbuf + 8192, 1); MLA_MM(p, va0, vc0); }
          { const bf16x8 p = MLA_PACK(s2, 1); MLA_VRD(va0, vc0, vbuf + 8192, 2); MLA_MM(p, va1, vc1); }
          { const bf16x8 p = MLA_PACK(s3, 0); MLA_VRD(va1, vc1, vbuf + 8192, 3); MLA_MM(p, va0, vc0); }
          { const bf16x8 p = MLA_PACK(s3, 1); MLA_MM(p, va1, vc1); } }
        __builtin_amdgcn_s_setprio(0);
    }
#undef MLA_LOAD
#undef MLA_STORE
#undef MLA_PACK
#undef MLA_VRD
#undef MLA_VRD0
#undef MLA_MM
#undef MLA_PV
    const float ltot = lrun + __shfl_xor(lrun, 32);
    const float inv = 1.0f / ltot;
    bf16_t* op = A.o + (size_t)r32 * A.ldo + 4 * h;
#pragma unroll
    for (int g4 = 0; g4 < 4; ++g4) {
        u32x2 w;
        w.x = cvt_pk_bf16_m(o0[4 * g4 + 0] * inv, o0[4 * g4 + 1] * inv); w.y = cvt_pk_bf16_m(o0[4 * g4 + 2] * inv, o0[4 * g4 + 3] * inv);
        *(u32x2*)(op + 8 * g4) = w;
        w.x = cvt_pk_bf16_m(o1[4 * g4 + 0] * inv, o1[4 * g4 + 1] * inv); w.y = cvt_pk_bf16_m(o1[4 * g4 + 2] * inv, o1[4 * g4 + 3] * inv);
        *(u32x2*)(op + 32 + 8 * g4) = w;
    }
    __syncthreads();
}

template <int DQ>
__device__ __forceinline__ void attn_unit(LAS unsigned char* lds, const AttnDesc& A, int tid_in, int wid, int lane_in) {
    constexpr int KSTR = (DQ + 8) * 2, NS = DQ / 16;
    int tid = tid_in; asm volatile("" : "+v"(tid));
    const int lane = tid & 63; (void)lane_in;
    const int r32 = lane & 31, h = lane >> 5;
    const int nt = A.nloc + 4;
    bf16x8 qf[NS];
#pragma unroll
    for (int s = 0; s < NS; ++s) qf[s] = *(const bf16x8*)(A.q + (size_t)r32 * A.ldq + 16 * s + 8 * h);
    f32x16 o0, o1;
#pragma unroll
    for (int r = 0; r < 16; ++r) { o0[r] = 0.f; o1[r] = 0.f; }
    float mrun = -1e30f, lrun = 0.f;
    f32x16 zero16;
#pragma unroll
    for (int r = 0; r < 16; ++r) zero16[r] = 0.f;
    asm volatile("" : "+v"(zero16));
    const int skey = tid >> 3, sch = tid & 7;
    u32x4 kreg, vreg, krreg = (u32x4){0u, 0u, 0u, 0u};
    {
        const int row0 = (0 < A.nloc) ? A.loc_row0 : A.ctx_row0;
        kreg = *(const u32x4*)(A.k + (size_t)(row0 + skey) * A.ldk + 8 * sch);
        vreg = *(const u32x4*)(A.v + (size_t)(row0 + skey) * A.ldv + 8 * sch);
        if (DQ == 96 && tid < 256) krreg = *(const u32x4*)(A.kr + (size_t)(row0 + (tid >> 2)) * A.ldkr + 8 * (tid & 3));
    }
    const LAS float* rpbl = (const LAS float*)(lds + ATT_RPB);
    const int vtr_off = ((lane & 15) >> 2) * 64 + (16 * ((lane >> 4) & 1) + 4 * (lane & 3)) * 2 + 4 * h * 64;
    for (int t = 0; t < nt; ++t) {
        LAS unsigned char* kb = lds + (t & 1) * ATT_KBUF;
        LAS unsigned char* vb = lds + ATT_VOFF + (t & 1) * 8192;
        *(LAS u32x4*)(kb + skey * KSTR + sch * 16) = kreg;
        if (DQ == 96 && tid < 256) *(LAS u32x4*)(kb + (tid >> 2) * KSTR + 128 + (tid & 3) * 16) = krreg;
        *(LAS u32x4*)(vb + (sch >> 2) * 4096 + skey * 64 + (sch & 3) * 16) = vreg;
        __syncthreads();
        if (t + 1 < nt) {
            const int t1 = t + 1;
            const int row0 = (t1 < A.nloc) ? A.loc_row0 + 64 * t1 : A.ctx_row0 + 64 * (t1 - A.nloc);
            kreg = *(const u32x4*)(A.k + (size_t)(row0 + skey) * A.ldk + 8 * sch);
            vreg = *(const u32x4*)(A.v + (size_t)(row0 + skey) * A.ldv + 8 * sch);
            if (DQ == 96 && tid < 256) krreg = *(const u32x4*)(A.kr + (size_t)(row0 + (tid >> 2)) * A.ldkr + 8 * (tid & 3));
        }
        const bool loc = t < A.nloc;
        bool act = true;
        if (A.mode == 1 && loc) { const int kr = A.a0 + t; act = (kr >= A.a2) && (kr < A.a2 + 8); }
        if (act) {
            f32x16 s0, s1;
            bf16x8 kq[2][2];
            kq[0][0] = *(const LAS bf16x8*)(kb + r32 * KSTR + (8 * h) * 2); kq[0][1] = *(const LAS bf16x8*)(kb + (32 + r32) * KSTR + (8 * h) * 2);
            __builtin_amdgcn_sched_group_barrier(0x100, 2, 0);
#pragma unroll
            for (int s = 0; s < NS; ++s) {
                if (s + 1 < NS) {
                    kq[(s + 1) & 1][0] = *(const LAS bf16x8*)(kb + r32 * KSTR + (16 * (s + 1) + 8 * h) * 2);
                    kq[(s + 1) & 1][1] = *(const LAS bf16x8*)(kb + (32 + r32) * KSTR + (16 * (s + 1) + 8 * h) * 2);
                    __builtin_amdgcn_sched_group_barrier(0x100, 2, 0);
                }
                s0 = __builtin_amdgcn_mfma_f32_32x32x16_bf16(kq[s & 1][0], qf[s], s == 0 ? zero16 : s0, 0, 0, 0);
                s1 = __builtin_amdgcn_mfma_f32_32x32x16_bf16(kq[s & 1][1], qf[s], s == 0 ? zero16 : s1, 0, 0, 0);
                __builtin_amdgcn_sched_group_barrier(0x008, 2, 0);
            }
            if (loc && A.mode == 1) {
                const int qc = 32 * (wid & 1) + r32;
                const int w0 = min(max(qc - 8, 0), 48);
                const int rbase = (A.a0 + t - A.a1 + 7) * 31;
#pragma unroll
                for (int r = 0; r < 16; ++r) {
                    const int kc = (r & 3) + 8 * (r >> 2) + 4 * h;
                    { const int dc = min(max(kc - qc + 15, 0), 30); const bool ok = (unsigned)(kc - w0) < 16u; const float bv = rpbl[rbase + dc]; s0[r] = ok ? s0[r] + bv : -1e30f; }
                    { const int kc2 = kc + 32; const int dc = min(max(kc2 - qc + 15, 0), 30); const bool ok = (unsigned)(kc2 - w0) < 16u; const float bv = rpbl[rbase + dc]; s1[r] = ok ? s1[r] + bv : -1e30f; }
                }
            } else if (loc && A.mode == 2) {
                const int p0 = A.a0 + 64 * t;
                if (p0 < A.a1 + 31 - 128 || p0 + 63 > A.a1 + 128) {
                    const int dbase = p0 - (A.a1 + r32);
#pragma unroll
                    for (int r = 0; r < 16; ++r) {
                        const int kc = (r & 3) + 8 * (r >> 2) + 4 * h;
                        s0[r] = ((unsigned)(dbase + kc + 128) > 256u) ? -1e30f : s0[r];
                        s1[r] = ((unsigned)(dbase + kc + 32 + 128) > 256u) ? -1e30f : s1[r];
                    }
                }
            }
            float mxa = fmaxf(fmaxf(s0[0], s0[1]), s0[2]), mxb = fmaxf(fmaxf(s1[0], s1[1]), s1[2]);
            mxa = fmaxf(fmaxf(mxa, s0[3]), s0[4]); mxb = fmaxf(fmaxf(mxb, s1[3]), s1[4]);
            mxa = fmaxf(fmaxf(mxa, s0[5]), s0[6]); mxb = fmaxf(fmaxf(mxb, s1[5]), s1[6]);
            mxa = fmaxf(fmaxf(mxa, s0[7]), s0[8]); mxb = fmaxf(fmaxf(mxb, s1[7]), s1[8]);
            mxa = fmaxf(fmaxf(mxa, s0[9]), s0[10]); mxb = fmaxf(fmaxf(mxb, s1[9]), s1[10]);
            mxa = fmaxf(fmaxf(mxa, s0[11]), s0[12]); mxb = fmaxf(fmaxf(mxb, s1[11]), s1[12]);
            mxa = fmaxf(fmaxf(mxa, s0[13]), s0[14]); mxb = fmaxf(fmaxf(mxb, s1[13]), s1[14]);
            float mx = fmaxf(fmaxf(mxa, mxb), fmaxf(s0[15], s1[15]));
            mx = fmaxf(mx, __shfl_xor(mx, 32));
            if (__builtin_amdgcn_ballot_w64(mx > mrun + 8.0f) != 0ull) {
                const float mnew = fmaxf(mrun, mx);
                const float alpha = __builtin_amdgcn_exp2f(mrun - mnew);
                mrun = mnew; lrun *= alpha;
#pragma unroll
                for (int r = 0; r < 16; ++r) { o0[r] *= alpha; o1[r] *= alpha; }
            }
            float rsa = 0.f, rsb = 0.f;
#pragma unroll
            for (int r = 0; r < 16; ++r) { s0[r] = __builtin_amdgcn_exp2f(s0[r] - mrun); s1[r] = __builtin_amdgcn_exp2f(s1[r] - mrun); rsa += s0[r]; rsb += s1[r]; }
            lrun += rsa + rsb;
            bf16x8 pf[4];
#pragma unroll
            for (int s2 = 0; s2 < 2; ++s2) {
                u32x4 w;
                w.x = cvt_pk_bf16_m(s0[8 * s2 + 0], s0[8 * s2 + 1]); w.y = cvt_pk_bf16_m(s0[8 * s2 + 2], s0[8 * s2 + 3]); w.z = cvt_pk_bf16_m(s0[8 * s2 + 4], s0[8 * s2 + 5]); w.w = cvt_pk_bf16_m(s0[8 * s2 + 6], s0[8 * s2 + 7]);
                pf[s2] = __builtin_bit_cast(bf16x8, w);
                w.x = cvt_pk_bf16_m(s1[8 * s2 + 0], s1[8 * s2 + 1]); w.y = cvt_pk_bf16_m(s1[8 * s2 + 2], s1[8 * s2 + 3]); w.z = cvt_pk_bf16_m(s1[8 * s2 + 4], s1[8 * s2 + 5]); w.w = cvt_pk_bf16_m(s1[8 * s2 + 6], s1[8 * s2 + 7]);
                pf[2 + s2] = __builtin_bit_cast(bf16x8, w);
            }
            bf16x8 vq[2][2];
#define ATT_VRD(SET, ks_) do { const LAS unsigned char* vp = vb + vtr_off + (ks_) * 16 * 64; \
                const s16x4 a0 = __builtin_bit_cast(s16x4, __builtin_amdgcn_ds_read_tr16_b64_v4i16((LAS s16x4*)(vp))); \
                const s16x4 a1 = __builtin_bit_cast(s16x4, __builtin_amdgcn_ds_read_tr16_b64_v4i16((LAS s16x4*)(vp + 8 * 64))); \
                const s16x4 c0 = __builtin_bit_cast(s16x4, __builtin_amdgcn_ds_read_tr16_b64_v4i16((LAS s16x4*)(vp + 4096))); \
                const s16x4 c1 = __builtin_bit_cast(s16x4, __builtin_amdgcn_ds_read_tr16_b64_v4i16((LAS s16x4*)(vp + 4096 + 8 * 64))); \
                vq[SET][0] = (bf16x8){a0[0], a0[1], a0[2], a0[3], a1[0], a1[1], a1[2], a1[3]}; vq[SET][1] = (bf16x8){c0[0], c0[1], c0[2], c0[3], c1[0], c1[1], c1[2], c1[3]}; } while (0)
            ATT_VRD(0, 0);
#pragma unroll
            for (int ks = 0; ks < 4; ++ks) {
                if (ks + 1 < 4) ATT_VRD((ks + 1) & 1, ks + 1);
                o0 = __builtin_amdgcn_mfma_f32_32x32x16_bf16(vq[ks & 1][0], pf[ks], o0, 0, 0, 0);
                o1 = __builtin_amdgcn_mfma_f32_32x32x16_bf16(vq[ks & 1][1], pf[ks], o1, 0, 0, 0);
            }
#undef ATT_VRD
        }
    }
    float ltot = lrun + __shfl_xor(lrun, 32);
    ltot += __builtin_amdgcn_exp2f(A.sink - mrun);
    const float inv = 1.0f / ltot;
    bf16_t* op = A.o + (size_t)r32 * A.ldo + 4 * h;
#pragma unroll
    for (int g4 = 0; g4 < 4; ++g4) {
        u32x2 w;
        w.x = cvt_pk_bf16_m(o0[4 * g4 + 0] * inv, o0[4 * g4 + 1] * inv); w.y = cvt_pk_bf16_m(o0[4 * g4 + 2] * inv, o0[4 * g4 + 3] * inv);
        *(u32x2*)(op + 8 * g4) = w;
        w.x = cvt_pk_bf16_m(o1[4 * g4 + 0] * inv, o1[4 * g4 + 1] * inv); w.y = cvt_pk_bf16_m(o1[4 * g4 + 2] * inv, o1[4 * g4 + 3] * inv);
        *(u32x2*)(op + 32 + 8 * g4) = w;
    }
    __syncthreads();
}


#define XB_TMO      128
#define XB_XCNT(j)  (256  + 64 * (j))
#define XB_XSUB(j)  (1280 + 64 * (j))
#define XB_XGEN(j)  (2304 + 64 * (j))
#define XB_TOP      3328
#define XB_TOPGEN   3392
#define XCD_BAR_WORDS 3456
#define XB_SPIN_CAP (1u << 18)
__device__ __forceinline__ unsigned xb_ld(unsigned* p)              { return __hip_atomic_load(p, __ATOMIC_RELAXED, __HIP_MEMORY_SCOPE_AGENT); }
__device__ __forceinline__ unsigned xb_add(unsigned* p, unsigned v) { return __hip_atomic_fetch_add(p, v, __ATOMIC_RELAXED, __HIP_MEMORY_SCOPE_AGENT); }
__device__ __forceinline__ unsigned xb_xcc_id() { return (unsigned)__builtin_amdgcn_s_getreg((3 << 11) | 20) & 0xFu; }
#define XB_SPIN(cond, bar) do { unsigned _sp = 0; while (cond) { __builtin_amdgcn_s_sleep(1); \
    if ((++_sp & 255u) == 0u) { if (xb_ld(&(bar)[XB_TMO])) break; if (_sp > XB_SPIN_CAP) { atomicAdd(&(bar)[XB_TMO], 1u); break; } } } } while (0)
struct XcdBarrier { unsigned* bar; unsigned x; volatile LAS unsigned* st; };
__device__ __forceinline__ XcdBarrier xcd_barrier_post(unsigned* bar, volatile LAS unsigned* st) {
    XcdBarrier b; b.bar = bar; b.x = xb_xcc_id(); b.st = st;
    if (threadIdx.x == 0) (void)xb_add(&bar[XB_XCNT(b.x)], 1u);
    return b;
}
__device__ __forceinline__ void xcd_barrier_complete(unsigned* bar, unsigned x, unsigned& nloc, unsigned& nx) {
    const unsigned G = gridDim.x * gridDim.y * gridDim.z;
    unsigned sum, cnt, mine, sp = 0u;
    for (;;) {
        sum = 0u; cnt = 0u; mine = 0u;
#pragma unroll
        for (unsigned j = 0; j < 16; ++j) { const unsigned c = xb_ld(&bar[XB_XCNT(j)]); sum += c; cnt += (c > 0u) ? 1u : 0u; mine = (j == x) ? c : mine; }
        if (sum == G) break;
        __builtin_amdgcn_s_sleep(1);
        if ((++sp & 255u) == 0u) { if (xb_ld(&bar[XB_TMO])) break; if (sp > XB_SPIN_CAP) { atomicAdd(&bar[XB_TMO], 1u); break; } }
    }
    nloc = mine > 0u ? mine : 1u; nx = cnt > 0u ? cnt : 1u;
}
__device__ __forceinline__ void xcd_barrier(const XcdBarrier& b) {
    asm volatile("s_waitcnt vmcnt(0)" ::: "memory");
    __syncthreads();
    if (threadIdx.x == 0) {
        unsigned* bar = b.bar;
        __builtin_amdgcn_s_waitcnt(0);
        unsigned nloc = b.st[0], nx = b.st[1];
        if (nloc == 0u) { xcd_barrier_complete(bar, b.x, nloc, nx); b.st[0] = nloc; b.st[1] = nx; }
        const unsigned old = xb_add(&bar[XB_XSUB(b.x)], 1u);
        const unsigned gen = old / nloc;
        if (old + 1u == (gen + 1u) * nloc) {
            __builtin_amdgcn_fence(__ATOMIC_RELEASE, "agent");
            asm volatile("s_waitcnt vmcnt(0)" ::: "memory");
            const unsigned og = xb_add(&bar[XB_TOP], 1u);
            const unsigned tg = og / nx;
            if (og + 1u == (tg + 1u) * nx) xb_add(&bar[XB_TOPGEN], 1u);
            else XB_SPIN(xb_ld(&bar[XB_TOPGEN]) == tg, bar);
            __builtin_amdgcn_fence(__ATOMIC_ACQUIRE, "agent");
            xb_add(&bar[XB_XGEN(b.x)], 1u);
            asm volatile("s_waitcnt vmcnt(0)" ::: "memory");
        } else {
            XB_SPIN(xb_ld(&bar[XB_XGEN(b.x)]) == gen, bar);
            __builtin_amdgcn_fence(__ATOMIC_ACQUIRE, "agent");
            asm volatile("s_waitcnt vmcnt(0)" ::: "memory");
        }
    }
    __syncthreads();
}
constexpr int LDS_BARST = 131072 + 10240;

struct Args { const float* in[22]; float* out; unsigned char* ws; int ph_lo, ph_hi; };
enum { IN_X = 0, IN_C, IN_CTX, IN_CCTX, IN_WADA, IN_BADA, IN_RPB, IN_WINE, IN_QNORM, IN_WUQ, IN_KVNORM, IN_WUKV, IN_WOUTE, IN_WINO, IN_SINKS, IN_WOUTO, IN_WUP, IN_BUP, IN_CONVW, IN_CONVB, IN_WDOWN, IN_BDOWN };
constexpr int N_PHASES = 2 + 11 + 10 + 11 + 8;

__device__ __forceinline__ float wave_sum(float v) {
#pragma unroll
    for (int o = 1; o < 64; o <<= 1) v += __shfl_xor(v, o);
    return v;
}

__device__ __forceinline__ void conv_item(const float* W, int K, int N, int Np, bf16_t* WT, const float* kscale, int mapmode, LAS float* scr, int item, int lane) {
    const int nblk = Np / 64, kb = item / nblk, nb = item % nblk, k0 = 64 * kb, n0 = 64 * nb;
    int src0 = n0;
    if (mapmode == 1) { const int tl = n0 >> 8, i = n0 & 255; src0 = (i < 128) ? (128 * tl + i) : (FFH + 128 * tl + (i - 128)); }
    const int c4 = 4 * (lane & 15);
    const bool valid = (mapmode == 1) || (n0 + c4 < N);
#pragma unroll 8
    for (int j = 0; j < 16; ++j) { const int kk = 4 * j + (lane >> 4);
        f32x4 v = (f32x4){0.f, 0.f, 0.f, 0.f};
        if (valid) { v = *(const f32x4*)(W + (size_t)(k0 + kk) * N + src0 + c4); if (kscale) v = v * kscale[k0 + kk]; }
        LAS float* d = scr + kk * 65 + c4; d[0] = v[0]; d[1] = v[1]; d[2] = v[2]; d[3] = v[3]; }
    const int c = lane & 7;
#pragma unroll
    for (int j = 0; j < 8; ++j) { const int n = (lane >> 3) + 8 * j; const LAS float* sp = scr + (8 * c) * 65 + n;
        u32x4 o; o.x = cvt_pk_bf16(sp[0 * 65], sp[1 * 65]); o.y = cvt_pk_bf16(sp[2 * 65], sp[3 * 65]); o.z = cvt_pk_bf16(sp[4 * 65], sp[5 * 65]); o.w = cvt_pk_bf16(sp[6 * 65], sp[7 * 65]);
        *(u32x4*)(WT + (size_t)(n0 + n) * K + k0 + 8 * c) = o; }
}

__device__ __forceinline__ void sincos_d(double a, float& c, float& s) {
    const double twopi = 6.283185307179586476925;
    const double k = __builtin_rint(a / twopi);
    const double r = a - k * twopi;
    const double r2 = r * r;
    double cs = 1.0, sn = r, tc = 1.0, ts = r;
#pragma unroll 1
    for (int i = 1; i <= 14; ++i) { tc = -tc * r2 / (double)((2 * i - 1) * (2 * i)); ts = -ts * r2 / (double)((2 * i) * (2 * i + 1)); cs += tc; sn += ts; }
    c = (float)cs; s = (float)sn;
}

__global__ void __launch_bounds__(512, 2) mk_fwd(Args args) {
    extern __shared__ __attribute__((aligned(16))) unsigned char lds_raw[];
    LAS unsigned char* lds = (LAS unsigned char*)lds_raw;
    const int G = gridDim.x, NGW = G * 8;
    cg::grid_group grid = cg::this_grid();
    if (threadIdx.x == 0) { ((volatile LAS unsigned*)(lds + LDS_BARST))[0] = 0u; ((volatile LAS unsigned*)(lds + LDS_BARST))[1] = 0u; }
    __syncthreads();
    const XcdBarrier xbar = xcd_barrier_post((unsigned*)args.ws, (volatile LAS unsigned*)(lds + LDS_BARST));

    for (int ph = args.ph_lo; ph < args.ph_hi; ++ph) {
        unsigned char* ws = args.ws; asm volatile("" : "+s"(ws));
        float* MODS = (float*)(ws + WS_MODS);
        float* tabM = (float*)(ws + WS_TAB); float* tabS = tabM + 1024;
        float* XC = (float*)(ws + WS_XC); float* XL = args.out;
        bf16_t* WB = (bf16_t*)(ws + WS_W);
        bf16_t* HO = (bf16_t*)(ws + WS_HO);
        bf16_t* Z = (bf16_t*)(ws + WS_Z);
        bf16_t* Q2 = (bf16_t*)(ws + WS_Q2);
        bf16_t* KV2 = (bf16_t*)(ws + WS_KV2);
        bf16_t* GB = (bf16_t*)(ws + WS_G);
        float* HALO = (float*)(ws + WS_HALO);
        float* STAT = (float*)(ws + WS_STAT);
        float* SSQ = (float*)(ws + WS_SSQ);
        int l = 0, kind = 100 + ph;
        if (ph >= 2) {
            const unsigned long long SEQ_E = 0x0ull | (1ull << 4) | (2ull << 8) | (3ull << 12) | (4ull << 16) | (9ull << 20) | (5ull << 24) | (6ull << 28) | (7ull << 32) | (8ull << 36) | (10ull << 40);
            const unsigned long long SEQ_O = 0x0ull | (2ull << 4) | (3ull << 8) | (4ull << 12) | (9ull << 16) | (5ull << 20) | (6ull << 24) | (7ull << 28) | (8ull << 32) | (10ull << 36);
            const unsigned long long SEQ_L = 0x0ull | (2ull << 4) | (3ull << 8) | (4ull << 12) | (5ull << 16) | (6ull << 20) | (7ull << 24) | (8ull << 28);
            unsigned long long seq; int pos;
            if (ph < 13) { l = 0; seq = SEQ_E; pos = ph - 2; } else if (ph < 23) { l = 1; seq = SEQ_O; pos = ph - 13; } else if (ph < 34) { l = 2; seq = SEQ_E; pos = ph - 23; } else { l = 3; seq = SEQ_L; pos = ph - 34; }
            kind = (int)((seq >> (4 * pos)) & 15ull);
        }
        int cv_lo = 0, cv_hi = 0, cv_w = 0, cv_n = 1;
        if (ph == 0 && EN(100)) {
            GET_TID();
            for (int it = blockIdx.x; it < 768; it += G) {
                const int l = it / 192, col0 = (it % 192) * 32, d0 = wid * 128;
                LAS float* sc = (LAS float*)(lds + wid * 10240);
                for (int b = 0; b < 17; ++b)
#pragma unroll
                    for (int hh = 0; hh < 2; ++hh) { const int dd = lane + 64 * hh; const float x = (b < 16) ? args.in[IN_C][b * 1024 + d0 + dd] : args.in[IN_CCTX][d0 + dd]; sc[b * 128 + dd] = x / (1.0f + __expf(-x)); }
                float acc[17];
#pragma unroll
                for (int b = 0; b < 17; ++b) acc[b] = 0.f;
                const int hi = lane >> 5, cc = lane & 31;
                const float* wp = args.in[IN_WADA] + ((size_t)(l * 1024 + d0 + hi)) * 6144 + col0 + cc;
#pragma unroll 16
                for (int i = 0; i < 64; ++i) { const float w = wp[(size_t)(2 * i) * 6144];
#pragma unroll
                    for (int b = 0; b < 17; ++b) acc[b] += sc[b * 128 + 2 * i + hi] * w; }
                LAS float* red = (LAS float*)(lds + 81920);
#pragma unroll
                for (int b = 0; b < 17; ++b) { const float t = acc[b] + __shfl_xor(acc[b], 32); if (hi == 0) red[(wid * 17 + b) * 32 + cc] = t; }
                __syncthreads();
                for (int x = tid; x < 17 * 32; x += 512) { const int b = x >> 5, c2 = x & 31; float sm = args.in[IN_BADA][l * 6144 + col0 + c2];
#pragma unroll
                    for (int w = 0; w < 8; ++w) sm += red[(w * 17 + b) * 32 + c2];
                    MODS[(size_t)(l * 17 + b) * 6144 + col0 + c2] = sm; }
                __syncthreads();
            }
            if (blockIdx.x == G - 1) {
                for (int x = tid; x < 64 * 8 + 64 * 16; x += 512) {
                    const bool isM = x < 512; const int y = isM ? x : x - 512; const int nf = isM ? 8 : 16; const int pos = y / nf, f = y % nf;
                    const double base = isM ? 0.31622776601683794 : 0.5623413251903491;
                    double inv = 1.0; for (int i = 0; i < f; ++i) inv *= base;
                    const float ang = (float)pos * (float)inv;
                    float c, s; sincos_d((double)ang, c, s);
                    float* tp = isM ? tabM : tabS; tp[2 * y] = c; tp[2 * y + 1] = s;
                }
            }
            cv_lo = 0; cv_hi = 1; cv_w = gw; cv_n = NGW;
        } else if (ph == 1 && EN(101)) {
            GET_TID();
            for (int row = gw; row < MT; row += NGW) {
                const bool lat = row < ML;
                const float* xr = lat ? args.in[IN_X] + (size_t)row * DM : args.in[IN_CTX] + (size_t)(row - ML) * DM;
                const float* mp = MODS + (size_t)(lat ? (row >> 11) : 16) * 6144;
#pragma unroll
                for (int j = 0; j < 4; ++j) { const int col = 4 * lane + 256 * j;
                    const f32x4 v = *(const f32x4*)(xr + col), sh = *(const f32x4*)(mp + col), sc = *(const f32x4*)(mp + 1024 + col);
                    const f32x4 hv = v * (sc + 1.0f) + sh;
                    u32x2 w; w.x = cvt_pk_bf16(hv[0], hv[1]); w.y = cvt_pk_bf16(hv[2], hv[3]);
                    *(u32x2*)(HO + (size_t)row * DM + col) = w; }
            }
        } else {
            const int li = l >> 1; const bool even = !(l & 1); const bool with_ctx = l < 3;
            const float* modl = MODS + (size_t)l * 17 * 6144;
            const int Mrows = with_ctx ? MT : ML;
            if (kind == 0 && EN(0)) {
                pg8::Gemm g{HO, WB + w_win(l), MT, even ? ZE : ZO, DM, DM}; pg8::StaticOrder S; S.init(MT, g.N, G, (int)blockIdx.x);
                EpiZ E{Z, even ? ZE : ZO, even ? 0 : 1, tabM, tabS, SSQ};
                pg8::gemm_phase<EpiZ>(lds, g, S, E);
            } else if (kind == 1 && EN(1)) {
                for (int which = 0; which < 2; ++which) {
                    pg8::Gemm g; EpiQK E;
                    if (which == 0) { g = pg8::Gemm{Z + 1536, WB + w_uq(l), MT, 768, 384, ZE}; E = EpiQK{Q2, 768, SSQ, 12, 1.0f / 384.0f, 1, tabM}; }
                    else { g = pg8::Gemm{Z + 1920, WB + w_ukv(l), MT, 1024, 256, ZE}; E = EpiQK{KV2, 1024, SSQ + 12, 8, 1.0f / 256.0f, 0, tabM}; }
                    pg8::StaticOrder S; S.init(MT, g.N, G, (int)blockIdx.x);
                    pg8::gemm_phase<EpiQK>(lds, g, S, E);
                }
            } else if (kind == 2 && EN(2)) {
                GET_TID();
                const int nunits = with_ctx ? 2304 : 2048;
                LAS float* rpbl = (LAS float*)(lds + ATT_RPB);
                const int vblk = (G % 8 == 0) ? (int)(blockIdx.x % 8) * (G / 8) + (int)(blockIdx.x / 8) : (int)blockIdx.x;
                for (int ui = vblk; ui < nunits; ui += G) {
                    AttnDesc A; bool dq96 = false;
                    A.sink = -1e30f; A.mode = 0; A.a0 = 0; A.a1 = 0; A.a2 = 0; A.kr = Z; A.ldkr = 0; A.nloc = 0; A.loc_row0 = 0;
                    if (even) {
                        if (ui < 1024 || (ui >= 2048 && ui < 2176)) {
                            dq96 = true; int b, hh, qrow;
                            if (ui < 1024) { b = ui >> 6; hh = (ui >> 3) & 7; qrow = b * 2048 + 256 * (ui & 7); A.nloc = 32; A.loc_row0 = b * 2048; }
                            else { const int j = ui - 2048; b = j >> 3; hh = j & 7; qrow = ML + b * 256; }
                            qrow += 32 * wid; A.ctx_row0 = ML + b * 256;
                            A.q = Q2 + (size_t)qrow * 768 + 96 * hh; A.ldq = 768;
                            A.o = HO + (size_t)qrow * DM + 512 + 64 * hh; A.ldo = DM;
                            A.k = KV2 + 128 * hh; A.ldk = 1024; A.kr = Z + 2176; A.ldkr = ZE; A.v = KV2 + 128 * hh + 64; A.ldv = 1024;
                        } else {
                            int b, hh, qrow;
                            if (ui < 2048) { const int j = ui - 1024; b = j >> 6; hh = (j >> 3) & 7; const int R4 = j & 7; qrow = b * 2048 + 256 * R4;
                                const int lo = min(max(4 * R4 - 4, 0), 24), hi = min(max(4 * R4 - 1, 0), 24) + 8;
                                A.nloc = hi - lo; A.loc_row0 = b * 2048 + 64 * lo; A.mode = 1; A.a0 = lo; A.a1 = 4 * R4 + (wid >> 1); A.a2 = min(max(A.a1 - 4, 0), 24);
                                for (int x = tid; x < 465; x += 512) rpbl[x] = args.in[IN_RPB][(size_t)(li * 8 + hh) * 465 + x] * LOG2E;
                            } else { const int j = ui - 2176; b = j >> 3; hh = j & 7; qrow = ML + b * 256; }
                            qrow += 32 * wid; A.ctx_row0 = ML + b * 256;
                            A.q = Z + (size_t)qrow * ZE + 64 * hh; A.ldq = ZE; A.o = HO + (size_t)qrow * DM + 64 * hh; A.ldo = DM;
                            A.k = Z + 512 + 64 * hh; A.ldk = ZE; A.v = Z + 1024 + 64 * hh; A.ldv = ZE;
                        }
                    } else {
                        int b, qh, kvh, qrow;
                        if (ui < 2048) { b = ui >> 7; kvh = (ui >> 6) & 1; const int tb = ui & 63; const int q0 = 32 * tb; qh = 8 * kvh + wid; qrow = b * 2048 + q0;
                            const int ks64 = ((q0 - 128) >> 6) << 6;
                            const int tlo = ks64 < 0 ? (-ks64) >> 6 : 0; int thi = (2048 - ks64) >> 6; if (thi > 5) thi = 5;
                            A.nloc = thi - tlo; const int pos0 = ks64 + 64 * tlo; A.loc_row0 = b * 2048 + pos0; A.mode = 2; A.a0 = pos0; A.a1 = q0;
                        } else { const int j = ui - 2048; b = j >> 4; qh = j & 15; kvh = qh >> 3; qrow = ML + b * 256 + 32 * wid; }
                        A.ctx_row0 = ML + b * 256;
                        A.sink = args.in[IN_SINKS][li * 16 + qh] * LOG2E;
                        A.q = Z + (size_t)qrow * ZO + 64 * qh; A.ldq = ZO; A.o = HO + (size_t)qrow * DM + 64 * qh; A.ldo = DM;
                        A.k = Z + 1024 + 64 * kvh; A.ldk = ZO; A.v = Z + 1152 + 64 * kvh; A.ldv = ZO;
                    }
                    if (dq96) attn_unit_mla(lds, A, tid, wid, lane); else attn_unit<64>(lds, A, tid, wid, lane);
                }
            } else if ((kind == 3 || kind == 7 || ((kind == 4 || kind == 8) && with_ctx && (blockIdx.x & 3) == 0)) && EN(3)) {
                const bool ctxpart = (kind == 4 || kind == 8);
                const bool isout = (kind == 3 || kind == 4);
                pg8::Gemm g; EpiRes E;
                const float* sL = (l == 0 && isout) ? args.in[IN_X] : XL; const float* sC = (l == 0 && isout) ? args.in[IN_CTX] : XC;
                if (isout) { g = pg8::Gemm{HO, WB + w_wout(l), MT, DM, DM, DM}; E = EpiRes{sL, sC, XL, XC, modl + 2048, nullptr, (l == 0) ? nullptr : STAT}; }
                else { g = pg8::Gemm{GB, WB + w_down(l), MT, DM, FFH, FFH}; E = EpiRes{sL, sC, XL, XC, modl + 5120, args.in[IN_BDOWN] + l * 1024, STAT}; }
                pg8::StaticOrder S;
                if (ctxpart) S.init(MC, DM, G / 4, (int)(blockIdx.x >> 2), ML / 256); else S.init(ML, DM, G, (int)blockIdx.x);
                pg8::gemm_phase<EpiRes>(lds, g, S, E);
            } else if ((kind == 4 || kind == 8 || kind == 9 || kind == 10) && EN(4)) {
                GET_TID();
                const bool first = (kind == 4 || kind == 9);
                const bool lastln = (l == 3 && kind == 8);
                const float* mp0 = first ? modl + 3072 : (lastln ? modl : modl + 17 * 6144);
                int rbeg = 0, rend = ML, wstart = gw, wstride = NGW;
                if (kind == 9 || kind == 10) { rbeg = ML; rend = MT; }
                else if (with_ctx) { const int bi = (int)blockIdx.x - (int)(blockIdx.x >> 2) - 1; wstart = bi * 8 + wid; wstride = (G - G / 4) * 8; }
                auto ln_row = [&](const int row, f32x4 (&v)[4]) __attribute__((always_inline)) {
                    const bool lat = row < ML;
                    float* xr = lat ? XL + (size_t)row * DM : XC + (size_t)(row - ML) * DM;
                    const float* mp = mp0 + (size_t)(lat ? (row >> 11) : 16) * 6144;
                    float s = 0.f;
#pragma unroll
                    for (int j = 0; j < 4; ++j) s += (v[j][0] + v[j][1]) + (v[j][2] + v[j][3]);
                    const float mean = wave_sum(s) * (1.0f / DM); float s2 = 0.f;
#pragma unroll
                    for (int j = 0; j < 4; ++j) { v[j] = v[j] - mean; s2 += (v[j][0] * v[j][0] + v[j][1] * v[j][1]) + (v[j][2] * v[j][2] + v[j][3] * v[j][3]); }
                    const float rstd = 1.0f / sqrtf(wave_sum(s2) * (1.0f / DM) + LN_EPS);
                    if (lane == 0) { STAT[2 * (size_t)row] = mean; STAT[2 * (size_t)row + 1] = rstd; }
#pragma unroll
                    for (int j = 0; j < 4; ++j) { const int col = 4 * lane + 256 * j; const f32x4 y = v[j] * rstd;
                        if (lastln) *(f32x4*)(xr + col) = y;
                        if (!lastln) { const f32x4 sh = *(const f32x4*)(mp + col), sc = *(const f32x4*)(mp + 1024 + col); const f32x4 hv = y * (sc + 1.0f) + sh;
                            u32x2 w; w.x = cvt_pk_bf16(hv[0], hv[1]); w.y = cvt_pk_bf16(hv[2], hv[3]); *(u32x2*)(HO + (size_t)row * DM + col) = w; } }
                };
                for (int row0 = rbeg + wstart; row0 < rend; row0 += 2 * wstride) {
                    const int row1 = row0 + wstride; const bool has1 = row1 < rend;
                    f32x4 va[4], vb[4];
#pragma unroll
                    for (int j = 0; j < 4; ++j) vb[j] = (f32x4){0.f, 0.f, 0.f, 0.f};
                    { const float* xp = (row0 < ML) ? XL + (size_t)row0 * DM : XC + (size_t)(row0 - ML) * DM;
#pragma unroll
                      for (int j = 0; j < 4; ++j) va[j] = *(const f32x4*)(xp + 4 * lane + 256 * j); }
                    if (has1) { const float* xp = (row1 < ML) ? XL + (size_t)row1 * DM : XC + (size_t)(row1 - ML) * DM;
#pragma unroll
                      for (int j = 0; j < 4; ++j) vb[j] = *(const f32x4*)(xp + 4 * lane + 256 * j); }
                    ln_row(row0, va);
                    if (has1) ln_row(row1, vb);
                }
                if (kind == 8 && with_ctx) { cv_lo = l + 1; cv_hi = l + 2; cv_w = wstart; cv_n = wstride; }
            } else if (kind == 5 && EN(5)) {
                pg8::Gemm g{HO, WB + w_up(l), Mrows, FF2, DM, DM}; pg8::StaticOrder S; S.init(Mrows, FF2, G, (int)blockIdx.x);
                EpiUp E{GB, HALO, args.in[IN_BUP] + (size_t)l * FF2, args.in[IN_CONVW] + (size_t)l * 3 * FF2, args.in[IN_CONVB] + (size_t)l * FF2, (LAS float*)(lds + 131072)};
                pg8::gemm_phase<EpiUp>(lds, g, S, E);
            } else if (kind == 6 && EN(6)) {
                GET_TID();
                const int nitems = (Mrows / 64) * 2;
                const float* bup = args.in[IN_BUP]; (void)bup;
                const float* cw = args.in[IN_CONVW] + (size_t)l * 3 * FF2; const float* cb = args.in[IN_CONVB] + (size_t)l * FF2;
                for (int it = gw; it < nitems * 11; it += NGW) {
                    const int ri = it / 11, chunk = it - ri * 11;
                    const int g64 = ri >> 1, which = ri & 1; const int row = 64 * g64 + (which ? 63 : 0);
                    const int tpos = row < ML ? (row & 2047) : ((row - ML) & 255); const int tlen = row < ML ? 2048 : 256;
                    const float* hc = HALO + (size_t)(g64 * 4 + (which ? 3 : 0)) * FF2;
                    const float* hp = which ? HALO + (size_t)(g64 * 4 + 2) * FF2 : (tpos > 0 ? HALO + (size_t)((g64 - 1) * 4 + 3) * FF2 : nullptr);
                    const float* hn = which ? (tpos < tlen - 1 ? HALO + (size_t)((g64 + 1) * 4 + 0) * FF2 : nullptr) : HALO + (size_t)(g64 * 4 + 1) * FF2;
                    const int c = 256 * chunk + 4 * lane;
                    const int na = ((c >> 7) << 8) + (c & 127), ng = na + 128;
                    const f32x4 z4 = (f32x4){0.f, 0.f, 0.f, 0.f};
                    const f32x4 ac = *(const f32x4*)(hc + na), gc = *(const f32x4*)(hc + ng);
                    const f32x4 ap = hp ? *(const f32x4*)(hp + na) : z4, gp = hp ? *(const f32x4*)(hp + ng) : z4;
                    const f32x4 an = hn ? *(const f32x4*)(hn + na) : z4, gn = hn ? *(const f32x4*)(hn + ng) : z4;
                    const f32x4 av = *(const f32x4*)(cw + c) * ap + *(const f32x4*)(cw + FF2 + c) * ac + *(const f32x4*)(cw + 2 * FF2 + c) * an + *(const f32x4*)(cb + c);
                    const f32x4 gv = *(const f32x4*)(cw + FFH + c) * gp + *(const f32x4*)(cw + FF2 + FFH + c) * gc + *(const f32x4*)(cw + 2 * FF2 + FFH + c) * gn + *(const f32x4*)(cb + FFH + c);
                    f32x4 o;
#pragma unroll
                    for (int e = 0; e < 4; ++e) o[e] = av[e] * gv[e] / (1.0f + __expf(-gv[e]));
                    u32x2 w; w.x = cvt_pk_bf16(o[0], o[1]); w.y = cvt_pk_bf16(o[2], o[3]);
                    *(u32x2*)(GB + (size_t)row * FFH + c) = w;
                }
            }
        }
        if (cv_hi > cv_lo) {
            int tid2 = threadIdx.x; asm volatile("" : "+v"(tid2));
            const int lane2 = tid2 & 63, wid2 = __builtin_amdgcn_readfirstlane(tid2 >> 6);
            LAS float* scr = (LAS float*)(lds + wid2 * 16640);
            int base = 0;
            for (int l2 = cv_lo; l2 < cv_hi; ++l2) {
                const int i = l2 >> 1; const bool even2 = !(l2 & 1);
                for (int kd = 0; kd < 6; ++kd) {
                    const float* W; int K, N, Np, mapmode = 0; const float* ks = nullptr; size_t dst;
                    if (kd == 0) { if (even2) { W = args.in[IN_WINE] + (size_t)i * 1024 * 2208; K = 1024; N = 2208; Np = ZE; } else { W = args.in[IN_WINO] + (size_t)i * 1024 * 1280; K = 1024; N = 1280; Np = ZO; } dst = w_win(l2); }
                    else if (kd == 1) { if (!even2) continue; W = args.in[IN_WUQ] + (size_t)i * 384 * 768; K = 384; N = 768; Np = 768; ks = args.in[IN_QNORM] + i * 384; dst = w_uq(l2); }
                    else if (kd == 2) { if (!even2) continue; W = args.in[IN_WUKV] + (size_t)i * 256 * 1024; K = 256; N = 1024; Np = 1024; ks = args.in[IN_KVNORM] + i * 256; dst = w_ukv(l2); }
                    else if (kd == 3) { W = (even2 ? args.in[IN_WOUTE] : args.in[IN_WOUTO]) + (size_t)i * 1024 * 1024; K = 1024; N = 1024; Np = 1024; dst = w_wout(l2); }
                    else if (kd == 4) { W = args.in[IN_WUP] + (size_t)l2 * 1024 * FF2; K = 1024; N = FF2; Np = FF2; mapmode = 1; dst = w_up(l2); }
                    else { W = args.in[IN_WDOWN] + (size_t)l2 * FFH * 1024; K = FFH; N = 1024; Np = 1024; dst = w_down(l2); }
                    const int nitems = (K / 64) * (Np / 64);
                    int first = (cv_w - base) % cv_n; if (first < 0) first += cv_n;
                    for (int it = first; it < nitems; it += cv_n) conv_item(W, K, N, Np, WB + dst, ks, mapmode, scr, it, lane2);
                    base += nitems;
                }
            }
        }
        for (int xs = 0; xs < PROBE_XSYNC; ++xs) xcd_barrier(xbar);
        if (ph + 1 < args.ph_hi) { if (ph == 0) grid.sync(); else xcd_barrier(xbar); }
    }
}

extern "C" void kernel_launch(void* const* d_in, const int* in_sizes, int n_in, void* d_out, int out_size, void* d_ws, size_t ws_size, hipStream_t stream) {
    static int grid = 0;
    if (grid == 0) {
        if (n_in != 22 || ws_size < WS_END) { fprintf(stderr, "kernel_launch: unexpected inputs (n_in %d, ws %zu)\n", n_in, ws_size); grid = -1; return; }
        int dev = 0, cus = 0, per_cu = 0;
        hipGetDevice(&dev); hipDeviceGetAttribute(&cus, hipDeviceAttributeMultiprocessorCount, dev);
        hipFuncSetAttribute((const void*)mk_fwd, hipFuncAttributeMaxDynamicSharedMemorySize, LDS_BYTES);
        hipOccupancyMaxActiveBlocksPerMultiprocessor(&per_cu, (const void*)mk_fwd, 512, LDS_BYTES);
        if (per_cu < 1) { fprintf(stderr, "kernel_launch: occupancy query says %d blocks/CU\n", per_cu); per_cu = 1; }
        (void)hipGetLastError();
        grid = cus;
    }
    if (grid < 0) return;
    if (hipMemsetAsync(d_ws, 0, 16384, stream) != hipSuccess) { fprintf(stderr, "kernel_launch: memset failed\n"); return; }
    Args a{};
    for (int i = 0; i < 22; ++i) a.in[i] = (const float*)d_in[i];
    a.out = (float*)d_out; a.ws = (unsigned char*)d_ws;
#if MK_PER_PHASE_LAUNCH
    for (int ph = 0; ph < N_PHASES; ++ph) { a.ph_lo = ph; a.ph_hi = ph + 1; hipLaunchKernelGGL(mk_fwd, dim3(grid), dim3(512), LDS_BYTES, stream, a); }
#else
    a.ph_lo = 0; a.ph_hi = N_PHASES;
    void* kargs[] = {&a};
    hipError_t e = hipLaunchCooperativeKernel((const void*)mk_fwd, dim3(grid), dim3(512), kargs, LDS_BYTES, stream);
    if (e != hipSuccess) fprintf(stderr, "cooperative launch failed: %s (grid %d)\n", hipGetErrorString(e), grid);
#endif
}
```
